# Optimizing an MI355X kernel written in HIP

```python
import jax, jax.numpy as jnp
from jax import lax
import numpy as np

D_MODEL = 2048
BATCH = 2
SEQ = 4096
DEPTH = 2

D_MIX = D_MODEL
RWKV_HEAD_DIM = 64
RWKV_WIDTH = 3 * D_MIX // 8
RWKV_HEADS = RWKV_WIDTH // RWKV_HEAD_DIM
DECAY_LORA = 64
AAA_LORA = 64
GATE_LORA = 128
FOX_HEAD_DIM = 128
FOX_WIDTH = 3 * D_MIX // 8
FOX_HEADS = FOX_WIDTH // FOX_HEAD_DIM
FOX_BLOCK = 128
SG_GROUP_DIM = 128
SG_WIDTH = D_MIX - RWKV_WIDTH - FOX_WIDTH
SG_GROUPS = SG_WIDTH // SG_GROUP_DIM
SG_CHUNK = 128

C_R = 0
C_K = C_R + RWKV_WIDTH
C_V = C_K + RWKV_WIDTH
C_WD = C_V + RWKV_WIDTH
C_AD = C_WD + DECAY_LORA
C_GD = C_AD + AAA_LORA
C_RWKV_END = C_GD + GATE_LORA
C_Q = C_RWKV_END
C_FK = C_Q + FOX_WIDTH
C_FV = C_FK + FOX_WIDTH
C_FF = C_FV + FOX_WIDTH
C_U = C_FF + FOX_HEADS
C_SV = C_U + SG_WIDTH
N_IN = C_SV + SG_WIDTH

D_FF = 11 * D_MODEL // 4
N_EXPERTS = 8
TOP_K = 2
D_FF_EXPERT = D_FF // 2
N_DENSE = (DEPTH + 1) // 2
N_MOE = DEPTH // 2

N_MOD = 6
RMS_EPS = 1e-6
LN_EPS = 1e-5
LNX_EPS = 64e-5

kernel_name = "hybrid_rwkv7_fox_sgu_moe_adaln"


def rms_norm(x, g, eps=RMS_EPS):
    xf = x.astype(jnp.float32)
    y = xf * lax.rsqrt(jnp.mean(xf * xf, axis=-1, keepdims=True) + eps)
    return (y * g.astype(jnp.float32)).astype(x.dtype)


def standardize(x, eps):
    xf = x.astype(jnp.float32)
    mu = jnp.mean(xf, axis=-1, keepdims=True)
    var = jnp.mean(jnp.square(xf - mu), axis=-1, keepdims=True)
    return (xf - mu) * lax.rsqrt(var + eps)


def token_shift(z, mu):
    z_prev = jnp.pad(z, ((0, 0), (1, 0), (0, 0)))[:, :-1]
    return z + (z_prev - z) * mu


def swiglu(x, w1, w3, w2):
    return (jax.nn.silu(x @ w1) * (x @ w3)) @ w2


def rwkv7_group(z, w0, w2, a0, a2, g2, k_k, k_a, r_k, lnx_g, lnx_b):
    B, S, _ = z.shape
    dt = z.dtype
    zf = z.astype(jnp.float32)
    r = zf[..., C_R:C_K]
    k = zf[..., C_K:C_V]
    v = zf[..., C_V:C_WD]
    wd = zf[..., C_WD:C_AD]
    ad = zf[..., C_AD:C_GD]
    gd = zf[..., C_GD:C_RWKV_END]
    w_log = -jax.nn.softplus(-(w0.astype(jnp.float32) + jnp.tanh(wd) @ w2.astype(jnp.float32))) - 0.5
    decay = jnp.exp(-jnp.exp(w_log))
    a = jax.nn.sigmoid(a0.astype(jnp.float32) + ad @ a2.astype(jnp.float32))
    g = jax.nn.sigmoid(gd) @ g2.astype(jnp.float32)
    kk = k * k_k.astype(jnp.float32)
    k = k * (1.0 + (a - 1.0) * k_a.astype(jnp.float32))

    hd = lambda t: t.reshape(B, S, RWKV_HEADS, RWKV_HEAD_DIM)
    r_h, w_h, k_h, v_h, a_h, kk_h = hd(r), hd(decay), hd(k), hd(v), hd(a), hd(kk)
    kk_h = kk_h / jnp.maximum(jnp.sqrt(jnp.sum(kk_h * kk_h, axis=-1, keepdims=True)), 1e-12)

    def step(state, inp):
        r_t, w_t, k_t, v_t, kk_t, a_t = inp
        sa = jnp.einsum('bhvk,bhk->bhv', state, kk_t)
        state = (state * w_t[:, :, None, :]
                 - sa[..., None] * (kk_t * a_t)[:, :, None, :]
                 + v_t[..., None] * k_t[:, :, None, :])
        y = jnp.einsum('bhvk,bhk->bhv', state, r_t)
        return state, y

    xs = tuple(jnp.moveaxis(t, 1, 0) for t in (r_h, w_h, k_h, v_h, kk_h, a_h))
    state0 = jnp.zeros((B, RWKV_HEADS, RWKV_HEAD_DIM, RWKV_HEAD_DIM), jnp.float32)
    _, ys = lax.scan(step, state0, xs)
    y = jnp.moveaxis(ys, 0, 1)
    y = standardize(y, LNX_EPS).reshape(B, S, RWKV_WIDTH) * lnx_g.astype(jnp.float32) + lnx_b.astype(jnp.float32)
    bonus = jnp.sum(r_h * k_h * r_k.astype(jnp.float32), axis=-1, keepdims=True) * v_h
    out = (y + bonus.reshape(B, S, RWKV_WIDTH)) * g
    return out.astype(dt)


def fox_group(hz, qn_g, kn_g, fb):
    B, S, _ = hz.shape
    hds = lambda t: jnp.transpose(t.reshape(B, S, FOX_HEADS, FOX_HEAD_DIM), (0, 2, 1, 3))
    q = hds(rms_norm(hz[..., C_Q:C_FK].reshape(B, S, FOX_HEADS, FOX_HEAD_DIM), qn_g))
    k = hds(rms_norm(hz[..., C_FK:C_FV].reshape(B, S, FOX_HEADS, FOX_HEAD_DIM), kn_g))
    v = hds(hz[..., C_FV:C_FF])
    logf = jax.nn.log_sigmoid((hz[..., C_FF:C_U] + fb).astype(jnp.float32))
    cum = jnp.transpose(jnp.cumsum(logf, axis=1), (0, 2, 1))
    scale = FOX_HEAD_DIM ** -0.5
    outs = []
    for i in range(S // FOX_BLOCK):
        q0, q1 = i * FOX_BLOCK, (i + 1) * FOX_BLOCK
        qb = q[:, :, q0:q1]
        kb = k[:, :, :q1]
        vb = v[:, :, :q1]
        logits = (jnp.einsum('bhqd,bhkd->bhqk', qb, kb).astype(jnp.float32) * scale
                  + cum[:, :, q0:q1, None] - cum[:, :, None, :q1])
        causal = (q0 + jnp.arange(FOX_BLOCK))[:, None] >= jnp.arange(q1)[None, :]
        p = jax.nn.softmax(jnp.where(causal, logits, -jnp.inf), axis=-1)
        outs.append(jnp.einsum('bhqk,bhkd->bhqd', p.astype(vb.dtype), vb))
    o = jnp.concatenate(outs, axis=2)
    return jnp.transpose(o, (0, 2, 1, 3)).reshape(B, S, FOX_WIDTH)


def sgu_group(hz, ln_g, ln_b, ws, sb):
    B, S, _ = hz.shape
    u = jax.nn.gelu(hz[..., C_U:C_SV]).reshape(B, S, SG_GROUPS, SG_GROUP_DIM)
    v = jax.nn.gelu(hz[..., C_SV:N_IN]).reshape(B, S, SG_GROUPS, SG_GROUP_DIM)
    v = (standardize(v, LN_EPS) * ln_g.astype(jnp.float32) + ln_b.astype(jnp.float32)).astype(hz.dtype)
    v = v.reshape(B, S // SG_CHUNK, SG_CHUNK, SG_GROUPS, SG_GROUP_DIM)
    ws_c = ws * jnp.tril(jnp.ones((SG_CHUNK, SG_CHUNK), dtype=bool))
    mixed = jnp.einsum('gpq,bnqgc->bnpgc', ws_c, v) + jnp.transpose(sb)[None, None, :, :, None]
    return (u * mixed.reshape(B, S, SG_GROUPS, SG_GROUP_DIM)).reshape(B, S, SG_WIDTH)


def moe_ffn(h, router_w, router_b, w1, w3, w2):
    B, S, D = h.shape
    xf = h.reshape(B * S, D)
    logits = (xf @ router_w + router_b).astype(jnp.float32)
    top_v, top_i = lax.top_k(logits, TOP_K)
    top_w = jax.nn.softmax(top_v, axis=-1)
    gates = jnp.sum(jax.nn.one_hot(top_i, N_EXPERTS, dtype=jnp.float32) * top_w[..., None], axis=1)
    y = jnp.zeros_like(xf)
    for e in range(N_EXPERTS):
        y = y + gates[:, e:e + 1].astype(xf.dtype) * swiglu(xf, w1[e], w3[e], w2[e])
    return y.reshape(B, S, D)


def setup_inputs(seed: int = 0) -> dict:
    key = jax.random.key(seed)
    keys = iter(jax.random.split(key, 48))
    L = DEPTH
    D = D_MODEL
    nrm = lambda shape, s: jax.random.normal(next(keys), shape, jnp.float32) * s
    uni = lambda shape, lo, hi: jax.random.uniform(next(keys), shape, jnp.float32, lo, hi)
    return {
        "x": nrm((BATCH, SEQ, D), 1.0),
        "c": nrm((BATCH, D), 1.0),
        "ada_w": nrm((L, D, N_MOD * D), 0.5 * D ** -0.5),
        "ada_b": nrm((L, N_MOD * D), 0.02),
        "norm1_g": 1.0 + nrm((L, D), 0.05),
        "norm2_g": 1.0 + nrm((L, D), 0.05),
        "w_in": nrm((L, D, N_IN), D ** -0.5),
        "shift_mu": uni((L, C_RWKV_END), 0.0, 1.0),
        "rw_w0": uni((L, RWKV_WIDTH), -6.0, -1.0),
        "rw_w2": nrm((L, DECAY_LORA, RWKV_WIDTH), 0.5 * DECAY_LORA ** -0.5),
        "rw_a0": nrm((L, RWKV_WIDTH), 0.5),
        "rw_a2": nrm((L, AAA_LORA, RWKV_WIDTH), 0.5 * AAA_LORA ** -0.5),
        "rw_g2": nrm((L, GATE_LORA, RWKV_WIDTH), GATE_LORA ** -0.5),
        "rw_k_k": 0.85 + nrm((L, RWKV_WIDTH), 0.05),
        "rw_k_a": 1.0 + nrm((L, RWKV_WIDTH), 0.05),
        "rw_r_k": nrm((L, RWKV_HEADS, RWKV_HEAD_DIM), 0.1),
        "rw_lnx_g": 1.0 + nrm((L, RWKV_WIDTH), 0.05),
        "rw_lnx_b": nrm((L, RWKV_WIDTH), 0.02),
        "fox_qn_g": 1.0 + nrm((L, FOX_HEAD_DIM), 0.05),
        "fox_kn_g": 1.0 + nrm((L, FOX_HEAD_DIM), 0.05),
        "fox_fb": 2.0 + nrm((L, FOX_HEADS), 0.5),
        "sg_ln_g": 1.0 + nrm((L, SG_GROUPS, SG_GROUP_DIM), 0.05),
        "sg_ln_b": nrm((L, SG_GROUPS, SG_GROUP_DIM), 0.02),
        "sg_ws": nrm((L, SG_GROUPS, SG_CHUNK, SG_CHUNK), SG_CHUNK ** -0.5),
        "sg_b": 1.0 + nrm((L, SG_GROUPS, SG_CHUNK), 0.1),
        "w_out": nrm((L, D_MIX, D), D_MIX ** -0.5),
        "ffn_w1": nrm((N_DENSE, D, D_FF), D ** -0.5),
        "ffn_w3": nrm((N_DENSE, D, D_FF), D ** -0.5),
        "ffn_w2": nrm((N_DENSE, D_FF, D), D_FF ** -0.5),
        "moe_router_w": nrm((N_MOE, D, N_EXPERTS), D ** -0.5),
        "moe_router_b": nrm((N_MOE, N_EXPERTS), 0.01),
        "moe_w1": nrm((N_MOE, N_EXPERTS, D, D_FF_EXPERT), D ** -0.5),
        "moe_w3": nrm((N_MOE, N_EXPERTS, D, D_FF_EXPERT), D ** -0.5),
        "moe_w2": nrm((N_MOE, N_EXPERTS, D_FF_EXPERT, D), D_FF_EXPERT ** -0.5),
    }


def reference(x, c, ada_w, ada_b, norm1_g, norm2_g, w_in, shift_mu, rw_w0, rw_w2, rw_a0, rw_a2,
              rw_g2, rw_k_k, rw_k_a, rw_r_k, rw_lnx_g, rw_lnx_b, fox_qn_g, fox_kn_g, fox_fb,
              sg_ln_g, sg_ln_b, sg_ws, sg_b, w_out, ffn_w1, ffn_w3, ffn_w2, moe_router_w,
              moe_router_b, moe_w1, moe_w3, moe_w2):
    cs = jax.nn.silu(c)
    for l in range(DEPTH):
        mod = (cs @ ada_w[l] + ada_b[l])[:, None, :]
        sh1, sc1, g1, sh2, sc2, g2 = jnp.split(mod, N_MOD, axis=-1)

        h = rms_norm(x, norm1_g[l]) * (1.0 + sc1) + sh1
        hz = h @ w_in[l]
        z_rwkv = token_shift(hz[..., :C_RWKV_END], shift_mu[l])
        o_a = rwkv7_group(z_rwkv, rw_w0[l], rw_w2[l], rw_a0[l], rw_a2[l], rw_g2[l], rw_k_k[l],
                          rw_k_a[l], rw_r_k[l], rw_lnx_g[l], rw_lnx_b[l])
        o_b = fox_group(hz, fox_qn_g[l], fox_kn_g[l], fox_fb[l])
        o_c = sgu_group(hz, sg_ln_g[l], sg_ln_b[l], sg_ws[l], sg_b[l])
        mix = jnp.concatenate([o_a, o_b, o_c], axis=-1) @ w_out[l]
        x = x + g1 * mix

        h2 = rms_norm(x, norm2_g[l]) * (1.0 + sc2) + sh2
        j = l // 2
        if l % 2 == 0:
            f = swiglu(h2, ffn_w1[j], ffn_w3[j], ffn_w2[j])
        else:
            f = moe_ffn(h2, moe_router_w[j], moe_router_b[j], moe_w1[j], moe_w3[j], moe_w2[j])
        x = x + g2 * f
    return x
```

```cpp
#include <hip/hip_runtime.h>
#include <cstdio>
#include <cstdint>


namespace pg8 {
#define PG8_LAS __attribute__((address_space(3)))
typedef unsigned short bf16_t;
typedef short bf16x8 __attribute__((ext_vector_type(8)));
typedef float f32x4 __attribute__((ext_vector_type(4)));
typedef unsigned u32x4 __attribute__((ext_vector_type(4)));
constexpr int BM = 256, BK = 64, HALF = 128, HTB = HALF * BK * 2, STAGE_BYTES = 8 * HTB, NXCD = 8, WGM = 4;

__host__ __device__ __forceinline__ int lds_byte(int r, int c) { const int st = (r >> 4) * 2 + (c >> 5), rr = r & 15, cc = c & 31, ob = rr * 64 + cc * 2; return st * 1024 + (ob ^ (((ob >> 9) & 1) << 5)); }
__host__ __device__ __forceinline__ void stage_rc(int b, int& R, int& C) { const int st = b / 1024, sb = b % 1024, swz = sb ^ (((sb >> 9) & 1) << 5); R = (st >> 1) * 16 + swz / 64; C = (st & 1) * 32 + (swz % 64) / 2; }
__host__ __device__ __forceinline__ int perm32(int rho) { const int n = rho >> 4, i = rho & 15; return 8 * (i >> 2) + 4 * n + (i & 3); }

struct Unit { int pm, pn; int kofs = 0, nt = 0, part = 0, pa = 0; };
struct Gemm { const bf16_t* A; const bf16_t* Bt; int M, N, K; int ld = 0; };

struct StaticOrder {
    static constexpr bool SPLITK = false, APA = false;
    int nM, nN, nwg, G, c;
    __host__ __device__ void init(int M, int N, int G_, int c_) { nM = M / BM; nN = N / BM; nwg = nM * nN; G = G_; c = c_; }
    __host__ __device__ bool next(int i, Unit& u) const {
        const long L = (long)i * G + c; if (L >= nwg) return false;
        int wgid = (int)L; { const int q = nwg / NXCD, r = nwg % NXCD, xcd = wgid % NXCD, off = wgid / NXCD; wgid = (xcd < r ? xcd * (q + 1) : r * (q + 1) + (xcd - r) * q) + off; }
        const int nig = WGM * nN, gid = wgid / nig, fm = gid * WGM, gsz = (nM - fm) < WGM ? (nM - fm) : WGM;
        u.pm = fm + ((wgid % nig) % gsz); u.pn = (wgid % nig) / gsz; return true;
    }
    __device__ __forceinline__ void a_ready(const Unit&) const {}
    __device__ __forceinline__ void done(const Unit&) const {}
};
struct MoeOrder {
    static constexpr bool SPLITK = false, APA = true;
    int t1, t2, t3, t4, t5, t6, t7, t8, ncol, G, c;
    __device__ __forceinline__ bool next(int i, Unit& u) const {
        const long L = (long)i * G + c; if (L >= (long)t8 * ncol) return false;
        const int T = (int)(L / ncol), j = (int)(L % ncol);
        const int e = (T >= t1) + (T >= t2) + (T >= t3) + (T >= t4) + (T >= t5) + (T >= t6) + (T >= t7);
        const int tb = e == 0 ? 0 : (e == 1 ? t1 : e == 2 ? t2 : e == 3 ? t3 : e == 4 ? t4 : e == 5 ? t5 : e == 6 ? t6 : t7);
        u.pm = T; u.pn = e * ncol + j; u.pa = e * 32 + (T - tb); return true;
    }
    __device__ __forceinline__ void a_ready(const Unit&) const {}
    __device__ __forceinline__ void done(const Unit&) const {}
};

struct MoeOrderSK {
    static constexpr bool SPLITK = true, APA = false;
    int t1, t2, t3, t4, t5, t6, t7, t8, ncol, G, c, full;
    __device__ __forceinline__ bool next(int i, Unit& u) const {
        const long L = (long)i * G + c; const int total = t8 * ncol; int Lu, part;
        if (L < full) { Lu = (int)L; part = 0; u.kofs = 0; u.nt = 44; }
        else { const long sidx = L - full; if (sidx >= (long)(total - full) * 4) return false;
            Lu = full + (int)(sidx >> 2); part = (int)(sidx & 3); u.kofs = (part * 12 - (part == 3 ? 2 : 0)) * BK; u.nt = 12 - 2 * (part >> 1); }
        const int T = Lu / ncol, j = Lu % ncol;
        const int e = (T >= t1) + (T >= t2) + (T >= t3) + (T >= t4) + (T >= t5) + (T >= t6) + (T >= t7);
        u.pm = T; u.pn = e * ncol + j; u.part = part; return true;
    }
    __device__ __forceinline__ void a_ready(const Unit&) const {}
    __device__ __forceinline__ void done(const Unit&) const {}
};

typedef float f32x2_cv __attribute__((ext_vector_type(2)));
typedef __bf16 bf16x2_cv __attribute__((ext_vector_type(2)));
__device__ __forceinline__ unsigned cvt_pk_bf16(float lo, float hi) { const f32x2_cv v = {lo, hi}; return __builtin_bit_cast(unsigned, __builtin_convertvector(v, bf16x2_cv)); }

struct EpiF32 {
    static constexpr bool PERM = false, AFTER_DRAIN = false;
    float* C; int ldc; int pnmod;
    __device__ __forceinline__ void operator()(const f32x4 (&acc)[2][2][4][2], const Unit& u, int wr, int wc, int fr, int fq) const {
        const int row0 = u.pm * BM + wr * 64 + fr, col0 = (u.pn % pnmod) * BM + wc * 32 + 4 * fq;
#pragma unroll
        for (int ai = 0; ai < 2; ++ai)
#pragma unroll
            for (int m = 0; m < 4; ++m) { float* rowp = C + (size_t)(row0 + ai * HALF + m * 16) * ldc + col0;
#pragma unroll
                for (int bj = 0; bj < 2; ++bj)
#pragma unroll
                    for (int n = 0; n < 2; ++n) *(f32x4*)(rowp + bj * HALF + n * 16) = acc[ai][bj][m][n]; }
    }
};
struct EpiBf16 {
    static constexpr bool PERM = true, AFTER_DRAIN = false;
    bf16_t* O; int ldc; int pnmod;
    __device__ __forceinline__ void operator()(const f32x4 (&acc)[2][2][4][2], const Unit& u, int wr, int wc, int fr, int fq) const {
        const int row0 = u.pm * BM + wr * 64 + fr, col0 = (u.pn % pnmod) * BM + wc * 32 + 8 * fq;
#pragma unroll
        for (int ai = 0; ai < 2; ++ai)
#pragma unroll
            for (int m = 0; m < 4; ++m) { bf16_t* rowp = O + (size_t)(row0 + ai * HALF + m * 16) * ldc + col0;
#pragma unroll
                for (int bj = 0; bj < 2; ++bj) { const f32x4 v0 = acc[ai][bj][m][0], v1 = acc[ai][bj][m][1];
                    u32x4 w; w.x = cvt_pk_bf16(v0[0], v0[1]); w.y = cvt_pk_bf16(v0[2], v0[3]); w.z = cvt_pk_bf16(v1[0], v1[1]); w.w = cvt_pk_bf16(v1[2], v1[3]);
                    *(u32x4*)(rowp + bj * HALF) = w; } }
    }
};
struct EpiBf16SK {
    static constexpr bool PERM = true, AFTER_DRAIN = false;
    bf16_t* O; bf16_t* O2; int ldc; int pnmod; int row_t;
    __device__ __forceinline__ void operator()(const f32x4 (&acc)[2][2][4][2], const Unit& u, int wr, int wc, int fr, int fq) const {
        const int row0 = u.pm * BM + wr * 64 + fr, col0 = (u.pn % pnmod) * BM + wc * 32 + 8 * fq;
        bf16_t* Ob = u.part == 0 ? O : O2 + ((long)(u.part - 1) * 2048 - row_t) * (long)ldc;
#pragma unroll
        for (int ai = 0; ai < 2; ++ai)
#pragma unroll
            for (int m = 0; m < 4; ++m) { bf16_t* rowp = Ob + (size_t)(row0 + ai * HALF + m * 16) * ldc + col0;
#pragma unroll
                for (int bj = 0; bj < 2; ++bj) { const f32x4 v0 = acc[ai][bj][m][0], v1 = acc[ai][bj][m][1];
                    u32x4 w; w.x = cvt_pk_bf16(v0[0], v0[1]); w.y = cvt_pk_bf16(v0[2], v0[3]); w.z = cvt_pk_bf16(v1[0], v1[1]); w.w = cvt_pk_bf16(v1[2], v1[3]);
                    *(u32x4*)(rowp + bj * HALF) = w; } }
    }
};
struct EpiRes {
    static constexpr bool PERM = false, AFTER_DRAIN = false;
    const float* xin; float* out; const float* gate; int gstride;
    __device__ __forceinline__ void operator()(const f32x4 (&acc)[2][2][4][2], const Unit& u, int wr, int wc, int fr, int fq) const {
        const int row0 = u.pm * BM + wr * 64 + fr, col0 = u.pn * BM + wc * 32 + 4 * fq;
        const float* gp = gate + (size_t)(u.pm >> 4) * gstride + col0;
        f32x4 gv[2][2];
#pragma unroll
        for (int bj = 0; bj < 2; ++bj)
#pragma unroll
            for (int n = 0; n < 2; ++n) gv[bj][n] = *(const f32x4*)(gp + bj * HALF + n * 16);
#pragma unroll
        for (int ai = 0; ai < 2; ++ai)
#pragma unroll
            for (int m = 0; m < 4; ++m) { const size_t ro = (size_t)(row0 + ai * HALF + m * 16) * 2048 + col0;
#pragma unroll
                for (int bj = 0; bj < 2; ++bj)
#pragma unroll
                    for (int n = 0; n < 2; ++n) { const f32x4 xv = *(const f32x4*)(xin + ro + bj * HALF + n * 16); *(f32x4*)(out + ro + bj * HALF + n * 16) = xv + gv[bj][n] * acc[ai][bj][m][n]; } }
    }
};
template <bool IN_BF16> struct EpiResB {
    static constexpr bool PERM = true, AFTER_DRAIN = false;
    const void* xin; bf16_t* out; const float* gate; int gstride;
    __device__ __forceinline__ void operator()(const f32x4 (&acc)[2][2][4][2], const Unit& u, int wr, int wc, int fr, int fq) const {
        const int row0 = u.pm * BM + wr * 64 + fr, col0 = u.pn * BM + wc * 32 + 8 * fq;
        const float* gp = gate + (size_t)(u.pm >> 4) * gstride + col0;
        f32x4 gv[2][2];
#pragma unroll
        for (int bj = 0; bj < 2; ++bj)
#pragma unroll
            for (int n = 0; n < 2; ++n) gv[bj][n] = *(const f32x4*)(gp + bj * HALF + 4 * n);
#pragma unroll
        for (int ai = 0; ai < 2; ++ai)
#pragma unroll
            for (int m = 0; m < 4; ++m) { const size_t ro = (size_t)(row0 + ai * HALF + m * 16) * 2048 + col0;
#pragma unroll
                for (int bj = 0; bj < 2; ++bj) { f32x4 x0, x1;
                    if (IN_BF16) { const u32x4 w = *(const u32x4*)((const bf16_t*)xin + ro + bj * HALF);
                        x0 = (f32x4){__uint_as_float(w.x << 16), __uint_as_float(w.x & 0xffff0000u), __uint_as_float(w.y << 16), __uint_as_float(w.y & 0xffff0000u)};
                        x1 = (f32x4){__uint_as_float(w.z << 16), __uint_as_float(w.z & 0xffff0000u), __uint_as_float(w.w << 16), __uint_as_float(w.w & 0xffff0000u)}; }
                    else { x0 = *(const f32x4*)((const float*)xin + ro + bj * HALF); x1 = *(const f32x4*)((const float*)xin + ro + bj * HALF + 4); }
                    const f32x4 v0 = x0 + gv[bj][0] * acc[ai][bj][m][0], v1 = x1 + gv[bj][1] * acc[ai][bj][m][1];
                    u32x4 o; o.x = cvt_pk_bf16(v0[0], v0[1]); o.y = cvt_pk_bf16(v0[2], v0[3]); o.z = cvt_pk_bf16(v1[0], v1[1]); o.w = cvt_pk_bf16(v1[2], v1[3]);
                    *(u32x4*)(out + ro + bj * HALF) = o; } }
    }
};
struct EpiSwiGLU {
    static constexpr bool PERM = true, AFTER_DRAIN = false;
    bf16_t* O; int ldc; int ncolmod;
    __device__ __forceinline__ void operator()(const f32x4 (&acc)[2][2][4][2], const Unit& u, int wr, int wc, int fr, int fq) const {
        const int row0 = u.pm * BM + wr * 64 + fr, col0 = (u.pn % ncolmod) * HALF + wc * 32 + 8 * fq;
#pragma unroll
        for (int ai = 0; ai < 2; ++ai)
#pragma unroll
            for (int m = 0; m < 4; ++m) { bf16_t* rowp = O + (size_t)(row0 + ai * HALF + m * 16) * ldc + col0;
                float v[8];
#pragma unroll
                for (int n = 0; n < 2; ++n)
#pragma unroll
                    for (int j = 0; j < 4; ++j) { const float a = acc[ai][0][m][n][j], b = acc[ai][1][m][n][j];
                        v[n * 4 + j] = a * __builtin_amdgcn_rcpf(1.0f + __builtin_amdgcn_exp2f(-1.4426950408889634f * a)) * b; }
                u32x4 w; w.x = cvt_pk_bf16(v[0], v[1]); w.y = cvt_pk_bf16(v[2], v[3]); w.z = cvt_pk_bf16(v[4], v[5]); w.w = cvt_pk_bf16(v[6], v[7]);
                *(u32x4*)rowp = w; }
    }
};

template <class Epi, class Sched, bool ALIGN_EPI = false, bool SP2 = false>
__device__ __forceinline__ void gemm_phase(PG8_LAS unsigned char* lds, const Gemm g, const Sched& S, const Epi& E) {
#ifdef DBG_LDSNAN
    for (int i = threadIdx.x; i < 131072 / 4; i += 512) ((PG8_LAS unsigned*)lds)[i] = 0x7FC07FC0u;
    __syncthreads();
#endif
    const int tid = threadIdx.x, wid = __builtin_amdgcn_readfirstlane(tid >> 6), lane = tid & 63, wr = wid >> 2, wc = wid & 3, fr = lane & 15, fq = lane >> 4;
    const int K = g.ld ? g.ld : g.K, nt = g.K / BK;
    unsigned voffA[2], voffB[2];
#pragma unroll
    for (int i = 0; i < 2; ++i) { int R, C; stage_rc(tid * 16 + i * 8192, R, C); const int Rb = Epi::PERM ? ((R & ~31) + perm32(R & 31)) : R;
        voffA[i] = (unsigned)(R * K + C) * 2u; voffB[i] = (unsigned)(Rb * K + C) * 2u; }
    const size_t kstep = (size_t)(BK * 2);
    const size_t hstep = (size_t)HALF * K * 2;
    const size_t tstep = 2 * hstep;
    const unsigned ldsw = (unsigned)wid * 1024u;
    const int aoff = lds_byte(wr * 64 + fr, fq * 8), boff = lds_byte(wc * 32 + fr, fq * 8);
#define PG8_SA(b, h) (((b) * 2 + (h)) * HTB)
#define PG8_SB(b, h) ((4 + (b) * 2 + (h)) * HTB)
#define PG8_STAGE(bufoff, gbase, voff) do { _Pragma("unroll") for (int _i = 0; _i < 2; ++_i) \
        __builtin_amdgcn_global_load_lds((const unsigned*)((const char*)(gbase) + (voff)[_i]), (PG8_LAS unsigned*)(lds + (bufoff) + ldsw + _i * 8192), 16, 0, 0); } while (0)
#define PG8_LDA(dst, b, h) do { _Pragma("unroll") for (int m = 0; m < 4; ++m) _Pragma("unroll") for (int k = 0; k < 2; ++k) dst[m][k] = *(const PG8_LAS bf16x8*)(lds + PG8_SA(b, h) + aoff + m * 2048 + k * 1024); } while (0)
#define PG8_LDB(dst, b, h) do { _Pragma("unroll") for (int n = 0; n < 2; ++n) _Pragma("unroll") for (int k = 0; k < 2; ++k) dst[n][k] = *(const PG8_LAS bf16x8*)(lds + PG8_SB(b, h) + boff + n * 2048 + k * 1024); } while (0)
#define PG8_MMA(ai, bj, At, Bt) do { __builtin_amdgcn_s_setprio(1); _Pragma("unroll") for (int m = 0; m < 4; ++m) _Pragma("unroll") for (int n = 0; n < 2; ++n) _Pragma("unroll") for (int k = 0; k < 2; ++k) \
        acc[ai][bj][m][n] = __builtin_amdgcn_mfma_f32_16x16x32_bf16(Bt[n][k], At[m][k], acc[ai][bj][m][n], 0, 0, 0); __builtin_amdgcn_s_setprio(0); } while (0)
#define PG8_WAIT_V(n) asm volatile("s_waitcnt vmcnt(" #n ")" ::: "memory")
#define PG8_WAIT_L(n) asm volatile("s_waitcnt lgkmcnt(" #n ")" ::: "memory")
#define PG8_BAR __builtin_amdgcn_s_barrier()
#define PG8_SCHED __builtin_amdgcn_sched_barrier(0)
    Unit cur, nxt; int ui = 0;
    if (!S.next(0, cur)) return;
    f32x4 acc[2][2][4][2];
#pragma unroll
    for (int a = 0; a < 2; ++a)
#pragma unroll
        for (int b = 0; b < 2; ++b)
#pragma unroll
            for (int m = 0; m < 4; ++m)
#pragma unroll
                for (int n = 0; n < 2; ++n) acc[a][b][m][n] = (f32x4){0.f, 0.f, 0.f, 0.f};
    bf16x8 At[4][2], B0[2][2], B1[2][2];
    const char* cA = (const char*)g.A + (size_t)(Sched::APA ? cur.pa : cur.pm) * tstep; const char* cB = (const char*)g.Bt + (size_t)cur.pn * tstep;
    if constexpr (Sched::SPLITK) { cA += (size_t)cur.kofs * 2; cB += (size_t)cur.kofs * 2; }
    S.a_ready(cur);
    if constexpr (SP2) {
        PG8_STAGE(PG8_SB(0, 0), cB, voffB); PG8_STAGE(PG8_SB(0, 1), cB + hstep, voffB); PG8_STAGE(PG8_SA(0, 0), cA, voffA); PG8_STAGE(PG8_SA(0, 1), cA + hstep, voffA);
        if (wr == 1) PG8_BAR;
        PG8_WAIT_V(2); PG8_BAR;
        PG8_STAGE(PG8_SB(1, 0), cB + kstep, voffB); PG8_STAGE(PG8_SA(1, 0), cA + kstep, voffA); PG8_STAGE(PG8_SB(1, 1), cB + hstep + kstep, voffB);
        PG8_WAIT_V(6); PG8_BAR;
    } else {
        PG8_STAGE(PG8_SB(0, 0), cB, voffB); PG8_STAGE(PG8_SA(0, 0), cA, voffA); PG8_STAGE(PG8_SB(0, 1), cB + hstep, voffB); PG8_STAGE(PG8_SA(0, 1), cA + hstep, voffA);
        if (wr == 1) PG8_BAR;
        PG8_WAIT_V(4); PG8_BAR;
        PG8_STAGE(PG8_SB(1, 0), cB + kstep, voffB); PG8_STAGE(PG8_SA(1, 0), cA + kstep, voffA); PG8_STAGE(PG8_SB(1, 1), cB + hstep + kstep, voffB);
        PG8_WAIT_V(6); PG8_BAR;
    }
    for (;;) {
        const bool has_next = S.next(ui + 1, nxt);
        const char* nA = has_next ? (const char*)g.A + (size_t)(Sched::APA ? nxt.pa : nxt.pm) * tstep : cA; const char* nB = has_next ? (const char*)g.Bt + (size_t)nxt.pn * tstep : cB;
        if constexpr (Sched::SPLITK) { if (has_next) { nA += (size_t)nxt.kofs * 2; nB += (size_t)nxt.kofs * 2; } }
        const int ntu = Sched::SPLITK ? cur.nt : nt;
        for (int t = 0; t < ntu; t += 2) {
            const bool last = (t == ntu - 2);
            const char* a1 = cA + (size_t)(t + 1) * kstep;
            const char* a2 = last ? nA : cA + (size_t)(t + 2) * kstep; const char* b2 = last ? nB : cB + (size_t)(t + 2) * kstep;
            const char* a3 = a2 + kstep; const char* b3 = b2 + kstep;
            if (last && has_next) S.a_ready(nxt);
            if constexpr (SP2) {
            PG8_LDB(B0, 0, 0); PG8_LDB(B1, 0, 1); PG8_SCHED; PG8_LDA(At, 0, 0); PG8_STAGE(PG8_SA(1, 1), a1 + hstep, voffA);
            PG8_WAIT_V(8); PG8_WAIT_L(0); PG8_BAR; PG8_MMA(0, 0, At, B0); PG8_MMA(0, 1, At, B1); PG8_BAR; PG8_SCHED;
            PG8_LDA(At, 0, 1); PG8_STAGE(PG8_SB(0, 0), b2, voffB); PG8_STAGE(PG8_SB(0, 1), b2 + hstep, voffB); PG8_STAGE(PG8_SA(0, 0), a2, voffA);
            PG8_WAIT_V(8); PG8_WAIT_L(0); PG8_BAR; PG8_MMA(1, 0, At, B0); PG8_MMA(1, 1, At, B1); PG8_BAR; PG8_SCHED;
            PG8_LDB(B0, 1, 0); PG8_LDB(B1, 1, 1); PG8_SCHED; PG8_LDA(At, 1, 0); PG8_STAGE(PG8_SA(0, 1), a2 + hstep, voffA);
            PG8_WAIT_V(8); PG8_WAIT_L(0); PG8_BAR; PG8_MMA(0, 0, At, B0); PG8_MMA(0, 1, At, B1); PG8_BAR; PG8_SCHED;
            PG8_LDA(At, 1, 1); PG8_STAGE(PG8_SB(1, 0), b3, voffB); PG8_STAGE(PG8_SB(1, 1), b3 + hstep, voffB); PG8_STAGE(PG8_SA(1, 0), a3, voffA);
            PG8_WAIT_V(8); PG8_WAIT_L(0); PG8_BAR; PG8_MMA(1, 0, At, B0); PG8_MMA(1, 1, At, B1); PG8_BAR; PG8_SCHED;
            } else {
            PG8_LDB(B0, 0, 0); PG8_SCHED; PG8_LDA(At, 0, 0); PG8_STAGE(PG8_SA(1, 1), a1 + hstep, voffA);
            PG8_WAIT_L(8); PG8_BAR; PG8_WAIT_L(0); PG8_MMA(0, 0, At, B0); PG8_BAR; PG8_SCHED;
            PG8_LDB(B1, 0, 1); PG8_STAGE(PG8_SB(0, 0), b2, voffB);
            PG8_BAR; PG8_WAIT_L(0); PG8_MMA(0, 1, At, B1); PG8_BAR;
            PG8_LDA(At, 0, 1); PG8_STAGE(PG8_SA(0, 0), a2, voffA);
            PG8_BAR; PG8_WAIT_L(0); PG8_MMA(1, 0, At, B0); PG8_BAR; PG8_SCHED;
            PG8_STAGE(PG8_SB(0, 1), b2 + hstep, voffB);
            PG8_WAIT_V(6); PG8_BAR; PG8_MMA(1, 1, At, B1); PG8_BAR;
            PG8_LDB(B0, 1, 0); PG8_SCHED; PG8_LDA(At, 1, 0); PG8_STAGE(PG8_SA(0, 1), a2 + hstep, voffA);
            PG8_WAIT_L(8); PG8_BAR; PG8_WAIT_L(0); PG8_MMA(0, 0, At, B0); PG8_BAR; PG8_SCHED;
            PG8_LDB(B1, 1, 1); PG8_STAGE(PG8_SB(1, 0), b3, voffB);
            PG8_BAR; PG8_WAIT_L(0); PG8_MMA(0, 1, At, B1); PG8_BAR;
            PG8_LDA(At, 1, 1); PG8_STAGE(PG8_SA(1, 0), a3, voffA);
            PG8_BAR; PG8_WAIT_L(0); PG8_MMA(1, 0, At, B0); PG8_BAR; PG8_SCHED;
            PG8_STAGE(PG8_SB(1, 1), b3 + hstep, voffB);
            PG8_WAIT_V(6); PG8_BAR; PG8_MMA(1, 1, At, B1); PG8_BAR;
            }
        }
        if constexpr (ALIGN_EPI) { if (wr == 0) PG8_BAR; }
        if constexpr (!Epi::AFTER_DRAIN) { E(acc, cur, wr, wc, fr, fq); S.done(cur); }
        if (!has_next) break;
#pragma unroll
        for (int a = 0; a < 2; ++a)
#pragma unroll
            for (int b = 0; b < 2; ++b)
#pragma unroll
                for (int m = 0; m < 4; ++m)
#pragma unroll
                    for (int n = 0; n < 2; ++n) acc[a][b][m][n] = (f32x4){0.f, 0.f, 0.f, 0.f};
        cur = nxt; cA = nA; cB = nB; ++ui;
        if constexpr (ALIGN_EPI) { if (wr == 1) PG8_BAR; }
    }
    PG8_WAIT_V(0);
    if constexpr (!ALIGN_EPI) { if (wr == 0) PG8_BAR; }
    PG8_BAR;
#undef PG8_SA
#undef PG8_SB
#undef PG8_STAGE
#undef PG8_LDA
#undef PG8_LDB
#undef PG8_MMA
#undef PG8_WAIT_V
#undef PG8_WAIT_L
#undef PG8_BAR
#undef PG8_SCHED
}
}

constexpr int LDS_BYTES = 147456;
constexpr int MISC_OFF = 131072 + 320;
constexpr int NWAVES = 8, NT = 512;
constexpr int D = 2048, SEQ = 4096, M = 8192;
constexpr int RW = 768, RH = 12;
constexpr int FH = 6;
constexpr int NHZ = 6144;
constexpr int HC_WD = 2304, HC_Q = 2560, HC_FK = 3328, HC_FV = 4096, HC_U = 4864, HC_SV = 5376, HC_FF = 5888;
constexpr int DFF = 5632, DFE = 2816, NE = 8;
constexpr int NMOD = 6 * D;
constexpr int MOE_ROWS = 18432;
constexpr float LOG2E = 1.4426950408889634f;

constexpr size_t MiB = 1u << 20;
constexpr size_t WS_CTL = 0, CTL_ZERO_BYTES = 1 * MiB;
constexpr size_t WS_MOD = 1 * MiB;
constexpr size_t WS_TOK = 2 * MiB;
constexpr size_t WS_BIAS = 3 * MiB;
constexpr size_t WS_WLT = 3 * MiB + 256 * 1024;
constexpr size_t WS_WIN = 4 * MiB;
constexpr size_t WS_WOUT = 52 * MiB;
constexpr size_t WS_W13 = 68 * MiB;
constexpr size_t WS_W2T = 112 * MiB;
constexpr size_t WS_MW13 = 134 * MiB;
constexpr size_t WS_MW2T = 310 * MiB;
constexpr size_t WS_HB = 398 * MiB;
constexpr size_t WS_OB = 430 * MiB;
constexpr size_t WS_X1 = 462 * MiB;
constexpr size_t WS_U = 526 * MiB;
constexpr size_t WS_HZ = WS_U;
constexpr size_t WS_RW = WS_U + 192 * MiB;
constexpr size_t RWSZ = 24 * MiB;
constexpr size_t WS_CHP = WS_RW;
constexpr size_t WS_CHR2 = WS_RW + 12 * MiB;
constexpr size_t WS_CHQ = WS_RW + 24 * MiB;
constexpr size_t WS_CHY0 = WS_RW + 48 * MiB;
constexpr size_t WS_CHHS = WS_RW + 72 * MiB;
constexpr size_t WS_Y = WS_RW + 84 * MiB;
constexpr size_t WS_VB = WS_RW + 108 * MiB;
constexpr size_t WS_GB = WS_RW + 120 * MiB;
constexpr size_t WS_BS = WS_RW + 132 * MiB;
constexpr size_t WS_YORA = WS_RW + 140 * MiB;
constexpr size_t WS_QF = WS_RW + 7 * RWSZ;
constexpr size_t WS_KF = WS_QF + 12 * MiB;
constexpr size_t WS_VT = WS_KF + 12 * MiB;
constexpr size_t WS_ACT = WS_U;
constexpr size_t WS_HS = WS_U + 100 * MiB;
constexpr size_t WS_YB = WS_U + 172 * MiB;
constexpr size_t WS_YB2 = WS_U + 244 * MiB;
constexpr size_t WS_END = WS_VT + 12 * MiB;
static_assert(WS_YB + (size_t)MOE_ROWS * 2048 * 4 <= WS_END, "ws map");
constexpr int CW_BAR = 4096;
constexpr int CW_ATQ = 20480;
constexpr int CW_CNT = 16384;
constexpr size_t TK_EXP = 0, TK_RANK = 65536 * 1, TK_GATE = 65536 * 2, TK_POS = 65536 * 3, TK_STOK = 65536 * 4;

#define GAS __attribute__((address_space(1)))
#define LAS __attribute__((address_space(3)))
typedef unsigned short bf16;
typedef unsigned v4u __attribute__((ext_vector_type(4)));
typedef unsigned v2u __attribute__((ext_vector_type(2)));
typedef float f32x4 __attribute__((ext_vector_type(4)));
typedef float f32x2 __attribute__((ext_vector_type(2)));
typedef short bf16x8 __attribute__((ext_vector_type(8)));
#define LDS_WAIT() asm volatile("s_waitcnt lgkmcnt(0)" ::: "memory")
#define VM_WAIT() asm volatile("s_waitcnt vmcnt(0)" ::: "memory")
__device__ __forceinline__ unsigned pk2(float lo, float hi) { return pg8::cvt_pk_bf16(lo, hi); }
__device__ __forceinline__ unsigned f2bf(float f) { return pg8::cvt_pk_bf16(f, f) & 0xffffu; }
#define DPP_F(v, ctrl) __builtin_bit_cast(float, __builtin_amdgcn_update_dpp(0, __builtin_bit_cast(int, (v)), (ctrl), 0xF, 0xF, false))
#define RDL_F(v, l) __builtin_bit_cast(float, __builtin_amdgcn_readlane(__builtin_bit_cast(int, (v)), (l)))
__device__ __forceinline__ float wave_sum(float v) {
    v += DPP_F(v, 0xB1); v += DPP_F(v, 0x4E); v += DPP_F(v, 0x141); v += DPP_F(v, 0x140);
    return (RDL_F(v, 15) + RDL_F(v, 31)) + (RDL_F(v, 47) + RDL_F(v, 63));
}
__device__ __forceinline__ float bf2f(unsigned short h) { return __uint_as_float(((unsigned)h) << 16); }
__device__ __forceinline__ void unpack8(const v4u w, float (&f)[8]) { f[0] = __uint_as_float(w.x << 16); f[1] = __uint_as_float(w.x & 0xffff0000u); f[2] = __uint_as_float(w.y << 16); f[3] = __uint_as_float(w.y & 0xffff0000u);
    f[4] = __uint_as_float(w.z << 16); f[5] = __uint_as_float(w.z & 0xffff0000u); f[6] = __uint_as_float(w.w << 16); f[7] = __uint_as_float(w.w & 0xffff0000u); }
__device__ __forceinline__ float wave_max(float v) {
    v = fmaxf(v, DPP_F(v, 0xB1)); v = fmaxf(v, DPP_F(v, 0x4E)); v = fmaxf(v, DPP_F(v, 0x141)); v = fmaxf(v, DPP_F(v, 0x140));
    return fmaxf(fmaxf(RDL_F(v, 15), RDL_F(v, 31)), fmaxf(RDL_F(v, 47), RDL_F(v, 63)));
}
__device__ __forceinline__ float wave_min(float v) { return -wave_max(-v); }
__device__ __forceinline__ float row16_sum(float v) { v += DPP_F(v, 0xB1); v += DPP_F(v, 0x4E); v += DPP_F(v, 0x141); v += DPP_F(v, 0x140); return v; }
__device__ __forceinline__ float quad_sum(float v) { v += DPP_F(v, 0xB1); v += DPP_F(v, 0x4E); return v; }
__device__ __forceinline__ float fast_sigmoid(float x) { return __builtin_amdgcn_rcpf(1.0f + __expf(-x)); }
__device__ __forceinline__ float fast_tanh(float x) { const float e = __expf(-2.0f * fabsf(x)); const float t = (1.0f - e) * __builtin_amdgcn_rcpf(1.0f + e); return x < 0.f ? -t : t; }
__device__ __forceinline__ float gelu_tanh(float x) { const float u2 = -2.302208198f * (x + 0.044715f * x * x * x); return x * __builtin_amdgcn_rcpf(1.0f + __builtin_amdgcn_exp2f(u2)); }
__device__ __forceinline__ float softplusf(float x) { return fmaxf(x, 0.f) + log1pf(__expf(-fabsf(x))); }
__device__ __forceinline__ float fast_softplus(float x) { return fmaxf(x, 0.f) + __logf(1.0f + __expf(-fabsf(x))); }

#define XB_TMO      128
#define XB_XCNT(j)  (256  + 64 * (j))
#define XB_XSUB(j)  (1280 + 64 * (j))
#define XB_XGEN(j)  (2304 + 64 * (j))
#define XB_TOP      3328
#define XB_TOPGEN   3392
#define XCD_BAR_WORDS 3456
#define XB_SPIN_CAP (1u << 18)
__device__ __forceinline__ unsigned xb_ld(unsigned* p)              { return __hip_atomic_load(p, __ATOMIC_RELAXED, __HIP_MEMORY_SCOPE_AGENT); }
__device__ __forceinline__ unsigned xb_add(unsigned* p, unsigned v) { return __hip_atomic_fetch_add(p, v, __ATOMIC_RELAXED, __HIP_MEMORY_SCOPE_AGENT); }
__device__ __forceinline__ unsigned xb_xcc_id() { return (unsigned)__builtin_amdgcn_s_getreg((3 << 11) | 20) & 0xFu; }
#define XB_SPIN(cond, bar) do { unsigned _sp = 0; while (cond) { __builtin_amdgcn_s_sleep(1); \
    if ((++_sp & 255u) == 0u) { if (xb_ld(&(bar)[XB_TMO])) break; if (_sp > XB_SPIN_CAP) { atomicAdd(&(bar)[XB_TMO], 1u); break; } } } } while (0)
struct XcdBarrier { unsigned* bar; unsigned x; volatile LAS unsigned* st; };
__device__ __forceinline__ XcdBarrier xcd_barrier_post(unsigned* bar, volatile LAS unsigned* st) {
    XcdBarrier b; b.bar = bar; b.x = xb_xcc_id(); b.st = st;
    if (threadIdx.x == 0) (void)xb_add(&bar[XB_XCNT(b.x)], 1u);
    return b;
}
__device__ __forceinline__ void xcd_barrier_complete(unsigned* bar, unsigned x, unsigned& nloc, unsigned& nx) {
    const unsigned G = gridDim.x * gridDim.y * gridDim.z;
    unsigned sum, cnt, mine, sp = 0u;
    for (;;) {
        sum = 0u; cnt = 0u; mine = 0u;
#pragma unroll
        for (unsigned j = 0; j < 16; ++j) { const unsigned c = xb_ld(&bar[XB_XCNT(j)]); sum += c; cnt += (c > 0u) ? 1u : 0u; mine = (j == x) ? c : mine; }
        if (sum == G) break;
        __builtin_amdgcn_s_sleep(1);
        if ((++sp & 255u) == 0u) { if (xb_ld(&bar[XB_TMO])) break; if (sp > XB_SPIN_CAP) { atomicAdd(&bar[XB_TMO], 1u); break; } }
    }
    nloc = mine > 0u ? mine : 1u; nx = cnt > 0u ? cnt : 1u;
}
__device__ __forceinline__ void xcd_barrier(const XcdBarrier& b) {
    asm volatile("s_waitcnt vmcnt(0)" ::: "memory");
    __syncthreads();
    if (threadIdx.x == 0) {
        unsigned* bar = b.bar;
        __builtin_amdgcn_s_waitcnt(0);
        unsigned nloc = b.st[0], nx = b.st[1];
        if (nloc == 0u) { xcd_barrier_complete(bar, b.x, nloc, nx); b.st[0] = nloc; b.st[1] = nx; }
        const unsigned old = xb_add(&bar[XB_XSUB(b.x)], 1u);
        const unsigned gen = old / nloc;
        if (old + 1u == (gen + 1u) * nloc) {
            __builtin_amdgcn_fence(__ATOMIC_RELEASE, "agent");
            asm volatile("s_waitcnt vmcnt(0)" ::: "memory");
            const unsigned og = xb_add(&bar[XB_TOP], 1u);
            const unsigned tg = og / nx;
            if (og + 1u == (tg + 1u) * nx) xb_add(&bar[XB_TOPGEN], 1u);
            else XB_SPIN(xb_ld(&bar[XB_TOPGEN]) == tg, bar);
            __builtin_amdgcn_fence(__ATOMIC_ACQUIRE, "agent");
            xb_add(&bar[XB_XGEN(b.x)], 1u);
            asm volatile("s_waitcnt vmcnt(0)" ::: "memory");
        } else {
            XB_SPIN(xb_ld(&bar[XB_XGEN(b.x)]) == gen, bar);
            __builtin_amdgcn_fence(__ATOMIC_ACQUIRE, "agent");
            asm volatile("s_waitcnt vmcnt(0)" ::: "memory");
        }
    }
    __syncthreads();
}

struct Args { const float* in[34]; float* out; unsigned char* ws; int ph_lo, ph_hi; };
enum { I_X = 0, I_C, I_ADAW, I_ADAB, I_N1G, I_N2G, I_WIN, I_MU, I_W0, I_W2, I_A0, I_A2, I_G2, I_KK, I_KA, I_RK, I_LNXG, I_LNXB, I_QNG, I_KNG, I_FB,
       I_SGLNG, I_SGLNB, I_SGWS, I_SGB, I_WOUT, I_FW1, I_FW3, I_FW2, I_MRW, I_MRB, I_MW1, I_MW3, I_MW2 };

struct CvtP { const float* src; bf16* dst; int ldw; int K; int nvalid; int pad; };
__device__ __forceinline__ void cvt_fill(CvtP& P, const float* W, int ldw, int K, int k0, int src_c0, int nvalid, bf16* WT, size_t dst_row0, int dst_koff) {
    P.src = W + (size_t)k0 * ldw + src_c0; P.dst = WT + dst_row0 * K + k0 + dst_koff; P.ldw = ldw; P.K = K; P.nvalid = nvalid; P.pad = 0; }
__device__ __forceinline__ void cvt_load(const CvtP& P, float (&v)[32], int lane) {
    const int j = lane & 31; const float* p = P.src + (size_t)(lane >> 5) * P.ldw + j; const bool ok = j < P.nvalid;
#pragma unroll
    for (int i = 0; i < 32; ++i) { v[i] = 0.f; if (ok) v[i] = *(const GAS float*)(p + (size_t)(2 * i) * P.ldw); }
}
__device__ __forceinline__ void cvt_finish(const CvtP& P, const float (&v)[32], LAS float* scr, int lane) {
#pragma unroll
    for (int i = 0; i < 32; ++i) scr[(2 * i + (lane >> 5)) * 33 + (lane & 31)] = v[i];
    LDS_WAIT(); asm volatile("" ::: "memory");
    const int c = lane & 7;
#pragma unroll
    for (int jj = 0; jj < 4; ++jj) { const int n = (lane >> 3) + 8 * jj; const LAS float* s = scr + (8 * c) * 33 + n;
        v4u o; o.x = pk2(s[0 * 33], s[1 * 33]); o.y = pk2(s[2 * 33], s[3 * 33]); o.z = pk2(s[4 * 33], s[5 * 33]); o.w = pk2(s[6 * 33], s[7 * 33]);
        *(GAS v4u*)(P.dst + (size_t)n * P.K + 8 * c) = o; }
    LDS_WAIT(); asm volatile("" ::: "memory");
}
constexpr int IT_WIN = 192 * 32, IT_WOUT = 64 * 32, IT_W13 = 352 * 32, IT_W2 = 64 * 88, IT_MW13 = 176 * 32, IT_MW2 = 64 * 44;
constexpr int IT_LORA = 192;
constexpr int IT_TOTAL = 2 * IT_WIN + 2 * IT_WOUT + IT_W13 + IT_W2 + 8 * IT_MW13 + 8 * IT_MW2 + IT_LORA;


__device__ __forceinline__ void cvt_decode(const Args& a, int it, CvtP& P) {
    unsigned char* ws = a.ws;
        int r = it;
        if (r < 2 * IT_WIN) { const int l = r / IT_WIN; r -= l * IT_WIN; const int kb = r / 192, g = r % 192, d0 = 32 * g;
            int sc0, nv; if (d0 < HC_U) { sc0 = d0; nv = 32; } else if (d0 < HC_FF) { sc0 = d0 + 6; nv = 32; } else if (d0 == HC_FF) { sc0 = 4864; nv = 6; } else { sc0 = 0; nv = 0; }
            cvt_fill(P, a.in[I_WIN] + (size_t)l * D * 5894, 5894, D, 64 * kb, sc0, nv, (bf16*)(ws + WS_WIN) + (size_t)l * NHZ * D, d0, 0); return; }
        r -= 2 * IT_WIN;
        if (r < 2 * IT_WOUT) { const int l = r / IT_WOUT; r -= l * IT_WOUT; const int kb = r / 64, g = r % 64;
            cvt_fill(P, a.in[I_WOUT] + (size_t)l * D * D, D, D, 64 * kb, 32 * g, 32, (bf16*)(ws + WS_WOUT) + (size_t)l * D * D, 32 * g, 0); return; }
        r -= 2 * IT_WOUT;
        if (r < IT_W13) { const int kb = r / 352, g = r % 352, p = g >> 3, s = (g >> 2) & 1, i0 = (g & 3) * 32;
            cvt_fill(P, s ? a.in[I_FW3] : a.in[I_FW1], DFF, D, 64 * kb, 128 * p + i0, 32, (bf16*)(ws + WS_W13), 32 * g, 0); return; }
        r -= IT_W13;
        if (r < IT_W2) { const int kb = r / 64, g = r % 64;
            cvt_fill(P, a.in[I_FW2], D, DFF, 64 * kb, 32 * g, 32, (bf16*)(ws + WS_W2T), 32 * g, 0); return; }
        r -= IT_W2;
        if (r < 8 * IT_MW13) { const int e = r / IT_MW13; r -= e * IT_MW13; const int kb = r / 176, g = r % 176, p = g >> 3, s = (g >> 2) & 1, i0 = (g & 3) * 32;
            cvt_fill(P, (s ? a.in[I_MW3] : a.in[I_MW1]) + (size_t)e * D * DFE, DFE, D, 64 * kb, 128 * p + i0, 32, (bf16*)(ws + WS_MW13) + (size_t)e * DFF * D, 32 * g, 0); return; }
        r -= 8 * IT_MW13;
        if (r >= 8 * IT_MW2) { r -= 8 * IT_MW2; const int l = r / 96; r -= l * 96; bf16* dst = (bf16*)(ws + WS_WLT) + (size_t)l * RW * 256;
            if (r < 24) cvt_fill(P, a.in[I_W2] + (size_t)l * 64 * RW, RW, 256, 0, 32 * r, 32, dst, 32 * r, 0);
            else if (r < 48) cvt_fill(P, a.in[I_A2] + (size_t)l * 64 * RW, RW, 256, 0, 32 * (r - 24), 32, dst, 32 * (r - 24), 64);
            else { const int q = r - 48, kb = q / 24, g = q % 24; cvt_fill(P, a.in[I_G2] + (size_t)l * 128 * RW, RW, 256, 64 * kb, 32 * g, 32, dst, 32 * g, 128); }
            return; }
        { const int e = r / IT_MW2; r -= e * IT_MW2; const int kb = r / 64, g = r % 64;
            cvt_fill(P, a.in[I_MW2] + (size_t)e * DFE * D, D, DFE, 64 * kb, 32 * g, 32, (bf16*)(ws + WS_MW2T) + (size_t)e * D * DFE, 32 * g, 0); }
}
__device__ __forceinline__ void p0_convert(const Args& a, LAS unsigned char* lds, int gw, int ngw, int wave, int lane) {
    LAS float* scr = (LAS float*)(lds + 32768 + wave * 8704);
#pragma unroll 1
    for (int it = gw; it < IT_TOTAL; it += 2 * ngw) {
        CvtP P0, P1; float v0[32], v1[32];
        cvt_decode(a, it, P0); cvt_load(P0, v0, lane);
        const bool two = it + ngw < IT_TOTAL;
        if (two) { cvt_decode(a, it + ngw, P1); cvt_load(P1, v1, lane); }
        cvt_finish(P0, v0, scr, lane);
        if (two) cvt_finish(P1, v1, scr, lane);
    }
}
__device__ __forceinline__ void p0_mod(const Args& a, LAS unsigned char* lds, int tid, int wave, int lane) {
    LAS float* cs = (LAS float*)lds;
    LAS float* red = (LAS float*)(lds + 16384);
    bool have = false;
    for (int u = blockIdx.x; u < 384; u += gridDim.x) {
        if (!have) { for (int i = tid; i < 4096; i += NT) { const float v = a.in[I_C][i]; cs[i] = v / (1.0f + __expf(-v)); } have = true; }
        __syncthreads();
        const int l = u / 192, jb = u % 192;
        const float* W = a.in[I_ADAW] + (size_t)l * D * NMOD + 64 * jb + lane;
        float a0 = 0.f, a1 = 0.f;
#pragma unroll 8
        for (int kk = 0; kk < 256; ++kk) { const int k = 256 * wave + kk; const float wv = W[(size_t)k * NMOD]; a0 += cs[k] * wv; a1 += cs[2048 + k] * wv; }
        red[(wave * 2 + 0) * 64 + lane] = a0; red[(wave * 2 + 1) * 64 + lane] = a1;
        __syncthreads();
        if (tid < 128) { const int b = tid >> 6, j = tid & 63; float s = 0.f;
#pragma unroll
            for (int w = 0; w < 8; ++w) s += red[(w * 2 + b) * 64 + j];
            ((float*)(a.ws + WS_MOD))[(size_t)(l * 2 + b) * NMOD + 64 * jb + j] = s + a.in[I_ADAB][(size_t)l * NMOD + 64 * jb + j]; }
    }
    __syncthreads();
}

template <bool MOE, bool INBF>
__device__ __forceinline__ void adaln_rows(const Args& a, const void* xin_, const float* g, const float* modl, int sh_off, int sc_off, bf16* out, int gw, int ngw, int lane, LAS unsigned char* lds = nullptr, int tid = 0) {
    f32x4 v[8];
    LAS f32x4* RWL = (LAS f32x4*)lds;
    if (MOE) {
        for (int idx = tid; idx < 4096; idx += NT) { const int ln = idx & 63, h = (idx >> 6) & 1, q = (idx >> 7) & 3, j = idx >> 9;
            RWL[idx] = *(const f32x4*)(a.in[I_MRW] + (size_t)(4 * (ln + 64 * j) + q) * NE + 4 * h); }
        __syncthreads();
    }
#define ADA_LOAD(dst, mrow) do { if (INBF) { const GAS v2u* xr_ = (const GAS v2u*)((const bf16*)xin_ + (size_t)(mrow) * D) + lane; \
            _Pragma("unroll") for (int j = 0; j < 8; ++j) { const v2u w_ = xr_[64 * j]; dst[j] = (f32x4){__uint_as_float(w_.x << 16), __uint_as_float(w_.x & 0xffff0000u), __uint_as_float(w_.y << 16), __uint_as_float(w_.y & 0xffff0000u)}; } } \
        else { const GAS f32x4* xr_ = (const GAS f32x4*)((const float*)xin_ + (size_t)(mrow) * D) + lane; _Pragma("unroll") for (int j = 0; j < 8; ++j) dst[j] = xr_[64 * j]; } } while (0)
    const int nrow = (M + ngw - 1) / ngw, m0 = gw * nrow, m1 = (m0 + nrow < M) ? m0 + nrow : M;
    f32x4 PA[8], PB[8]; int bcur = -1;
    auto params = [&](int b) { if (b != bcur) { bcur = b;
            const f32x4* gr = (const f32x4*)g + lane;
            const f32x4* scr = (const f32x4*)(modl + (size_t)b * NMOD + sc_off) + lane;
            const f32x4* shr = (const f32x4*)(modl + (size_t)b * NMOD + sh_off) + lane;
#pragma unroll
            for (int j = 0; j < 8; ++j) { PA[j] = gr[64 * j] * (scr[64 * j] + 1.0f); PB[j] = shr[64 * j]; } } };
    auto process = [&](const f32x4 (&v)[8], int m) {
        float ss = 0.f;
#pragma unroll
        for (int j = 0; j < 8; ++j) { ss += (v[j].x * v[j].x + v[j].y * v[j].y) + (v[j].z * v[j].z + v[j].w * v[j].w); }
        const float rstd = __builtin_amdgcn_rsqf(wave_sum(ss) * (1.0f / D) + 1e-6f);
        GAS v2u* o8 = (GAS v2u*)(out + (size_t)m * D) + lane;
        float lg[8]; v2u orow[8];
        LAS f32x4* rwl = RWL + lane; if (MOE) asm volatile("" : "+v"(rwl));
        if (MOE) {
#pragma unroll
            for (int e = 0; e < 8; ++e) lg[e] = 0.f; }
#pragma unroll
        for (int j = 0; j < 8; ++j) {
            f32x4 y = v[j] * rstd * PA[j] + PB[j];
            v2u o; o.x = pk2(y.x, y.y); o.y = pk2(y.z, y.w); if (MOE) orow[j] = o; else o8[64 * j] = o;
            if (MOE) {
#pragma unroll
                for (int q = 0; q < 4; ++q) { const f32x4 r0 = rwl[((j * 4 + q) * 2 + 0) * 64], r1 = rwl[((j * 4 + q) * 2 + 1) * 64]; const float yy = y[q];
                    lg[0] += yy * r0.x; lg[1] += yy * r0.y; lg[2] += yy * r0.z; lg[3] += yy * r0.w; lg[4] += yy * r1.x; lg[5] += yy * r1.y; lg[6] += yy * r1.z; lg[7] += yy * r1.w; } }
        }
        if (MOE) {
#pragma unroll
            for (int e = 0; e < 8; ++e) lg[e] = wave_sum(lg[e]) + a.in[I_MRB][e];
            int i0 = 0; float v0 = lg[0];
#pragma unroll
            for (int e = 1; e < 8; ++e) if (lg[e] > v0) { v0 = lg[e]; i0 = e; }
            int i1 = -1; float v1 = -3.0e38f;
#pragma unroll
            for (int e = 0; e < 8; ++e) if (e != i0 && lg[e] > v1) { v1 = lg[e]; i1 = e; }
            i0 = __builtin_amdgcn_readfirstlane(i0); i1 = __builtin_amdgcn_readfirstlane(i1);
            unsigned r0 = 0, r1 = 0;
            if (lane == 0) {
                const float w0 = 1.0f / (1.0f + __expf(v1 - v0)), w1 = 1.0f - w0;
                unsigned* cnt = (unsigned*)(a.ws + WS_CTL) + CW_CNT;
                r0 = xb_add(cnt + 64 * i0, 1u); r1 = xb_add(cnt + 64 * i1, 1u);
                unsigned char* tk = a.ws + WS_TOK;
                ((int*)(tk + TK_EXP))[m] = i0; ((int*)(tk + TK_EXP))[8192 + m] = i1;
                ((int*)(tk + TK_RANK))[m] = (int)r0; ((int*)(tk + TK_RANK))[8192 + m] = (int)r1;
                ((float*)(tk + TK_GATE))[m] = w0; ((float*)(tk + TK_GATE))[8192 + m] = w1;
            }
            r0 = (unsigned)__builtin_amdgcn_readfirstlane((int)r0); r1 = (unsigned)__builtin_amdgcn_readfirstlane((int)r1);
            GAS v2u* d0 = (GAS v2u*)(out + ((size_t)i0 * 8192 + r0) * D) + lane; GAS v2u* d1 = (GAS v2u*)(out + ((size_t)i1 * 8192 + r1) * D) + lane;
#pragma unroll
            for (int j = 0; j < 8; ++j) { d0[64 * j] = orow[j]; d1[64 * j] = orow[j]; }
        }
    };
    if constexpr (INBF) {
        for (int mg = m0; mg < m1; mg += 4) {
            params(mg >> 12);
            v2u raw[4][8];
#pragma unroll
            for (int r = 0; r < 4; ++r) if (mg + r < m1) { const GAS v2u* xr_ = (const GAS v2u*)((const bf16*)xin_ + (size_t)(mg + r) * D) + lane;
#pragma unroll
                for (int j = 0; j < 8; ++j) raw[r][j] = xr_[64 * j]; }
#pragma unroll
            for (int r = 0; r < 4; ++r) if (mg + r < m1) { params((mg + r) >> 12);
                f32x4 vv[8];
#pragma unroll
                for (int j = 0; j < 8; ++j) { const v2u w_ = raw[r][j]; vv[j] = (f32x4){__uint_as_float(w_.x << 16), __uint_as_float(w_.x & 0xffff0000u), __uint_as_float(w_.y << 16), __uint_as_float(w_.y & 0xffff0000u)}; }
                process(vv, mg + r); }
        }
    } else {
        if (m0 < m1) { params(m0 >> 12); ADA_LOAD(v, m0); }
        for (int m = m0; m < m1; ++m) {
            params(m >> 12);
            f32x4 vn[8];
            if (m + 1 < m1) ADA_LOAD(vn, m + 1);
            process(v, m);
#pragma unroll
            for (int j = 0; j < 8; ++j) v[j] = vn[j];
        }
    }
}

#define SW128(row, chunk) ((row) * 256 + ((((chunk) ^ ((row) & 15))) << 4))
__device__ __forceinline__ void sgu_unit(const Args& a, int l, int u, LAS unsigned char* lds, int tid, int wave, int lane) {
    const int g = u & 3, n = (u >> 2) & 31, b = u >> 7, fr = lane & 15, fq = lane >> 4;
    const bf16* HZ = (const bf16*)(a.ws + WS_HZ);
    LAS unsigned char* WSI = lds;
    LAS unsigned char* VTI = lds + 32768;
    const size_t m0 = (size_t)b * SEQ + n * 128;
    {   const int q = tid >> 2, c0 = (tid & 3) * 32;
        const bf16* src = HZ + (m0 + q) * NHZ + HC_SV + 128 * g + c0;
        float v[32]; float s = 0.f;
#pragma unroll
        for (int i = 0; i < 4; ++i) { float f8[8]; unpack8(*(const GAS v4u*)(src + 8 * i), f8);
#pragma unroll
            for (int e = 0; e < 8; ++e) v[8 * i + e] = gelu_tanh(f8[e]); }
#pragma unroll
        for (int i = 0; i < 32; ++i) s += v[i];
        s = quad_sum(s);
        const float mu = s * (1.0f / 128.0f); float q2 = 0.f;
#pragma unroll
        for (int i = 0; i < 32; ++i) { v[i] -= mu; q2 += v[i] * v[i]; }
        q2 = quad_sum(q2);
        const float rstd = __builtin_amdgcn_rsqf(q2 * (1.0f / 128.0f) + 1e-5f);
        const float* lg = a.in[I_SGLNG] + (size_t)(l * 4 + g) * 128 + c0; const float* lb = a.in[I_SGLNB] + (size_t)(l * 4 + g) * 128 + c0;
#pragma unroll
        for (int i = 0; i < 32; ++i) { const int c = c0 + i; *(LAS bf16*)(VTI + SW128(c, q >> 3) + (q & 7) * 2) = (bf16)f2bf(v[i] * rstd * lg[i] + lb[i]); }
        const int p = tid >> 2, q0 = (tid & 3) * 32; const float* wsrc = a.in[I_SGWS] + (size_t)(l * 4 + g) * 16384 + p * 128 + q0;
#pragma unroll
        for (int j = 0; j < 4; ++j) { const f32x4 w0 = *(const f32x4*)(wsrc + 8 * j), w1 = *(const f32x4*)(wsrc + 8 * j + 4); const int qq = q0 + 8 * j;
            v4u o; o.x = pk2(qq + 0 <= p ? w0.x : 0.f, qq + 1 <= p ? w0.y : 0.f); o.y = pk2(qq + 2 <= p ? w0.z : 0.f, qq + 3 <= p ? w0.w : 0.f);
            o.z = pk2(qq + 4 <= p ? w1.x : 0.f, qq + 5 <= p ? w1.y : 0.f); o.w = pk2(qq + 6 <= p ? w1.z : 0.f, qq + 7 <= p ? w1.w : 0.f);
            *(LAS v4u*)(WSI + SW128(p, qq >> 3)) = o; }
    }
    __syncthreads();
    {   const int pb = wave;
        const int nks = (16 * pb + 15) / 32 + 1;
        bf16x8 af[4];
#pragma unroll
        for (int ks = 0; ks < 4; ++ks) af[ks] = *(const LAS bf16x8*)(WSI + SW128(16 * pb + fr, 4 * ks + fq));
        bf16* OB = (bf16*)(a.ws + WS_OB);
        const float sbp = a.in[I_SGB][(size_t)(l * 4 + g) * 128 + 16 * pb + fr];
        const size_t prow = m0 + 16 * pb + fr;
        v2u uraw[8];
#pragma unroll
        for (int cb = 0; cb < 8; ++cb) uraw[cb] = *(const GAS v2u*)(HZ + prow * NHZ + HC_U + 128 * g + 16 * cb + 4 * fq);
#pragma unroll
        for (int cb = 0; cb < 8; ++cb) { f32x4 acc = (f32x4){0.f, 0.f, 0.f, 0.f};
#pragma unroll
            for (int ks = 0; ks < 4; ++ks) if (ks < nks) acc = __builtin_amdgcn_mfma_f32_16x16x32_bf16(*(const LAS bf16x8*)(VTI + SW128(16 * cb + fr, 4 * ks + fq)), af[ks], acc, 0, 0, 0);
            const float u0 = __uint_as_float(uraw[cb].x << 16), u1 = __uint_as_float(uraw[cb].x & 0xffff0000u), u2 = __uint_as_float(uraw[cb].y << 16), u3 = __uint_as_float(uraw[cb].y & 0xffff0000u);
            v2u o; o.x = pk2(gelu_tanh(u0) * (acc[0] + sbp), gelu_tanh(u1) * (acc[1] + sbp)); o.y = pk2(gelu_tanh(u2) * (acc[2] + sbp), gelu_tanh(u3) * (acc[3] + sbp));
            *(GAS v2u*)(OB + prow * D + 1536 + 128 * g + 16 * cb + 4 * fq) = o; }
    }
    __syncthreads();
}
__device__ __forceinline__ void fox_prep_unit(const Args& a, int l, int u, LAS unsigned char* lds, int tid, int wave, int lane) {
    const bf16* HZ = (const bf16*)(a.ws + WS_HZ);
    const int b = u >> 7, t0 = (u & 127) * 32;
    const size_t m0 = (size_t)b * SEQ + t0;
    bf16* QF = (bf16*)(a.ws + WS_QF); bf16* KF = (bf16*)(a.ws + WS_KF); bf16* VT = (bf16*)(a.ws + WS_VT);
    {   const int t = tid >> 4, d0 = (tid & 15) * 48; const bf16* src = HZ + (m0 + t) * NHZ + HC_FV + d0;
        v4u vv[6];
#pragma unroll
        for (int i = 0; i < 6; ++i) vv[i] = *(const GAS v4u*)(src + 8 * i);
#pragma unroll
        for (int i = 0; i < 6; ++i) { LAS unsigned char* p = lds + (d0 + 8 * i) * 68 + t * 2;
            *(LAS bf16*)(p) = (bf16)(vv[i].x & 0xffffu); *(LAS bf16*)(p + 68) = (bf16)(vv[i].x >> 16); *(LAS bf16*)(p + 136) = (bf16)(vv[i].y & 0xffffu); *(LAS bf16*)(p + 204) = (bf16)(vv[i].y >> 16);
            *(LAS bf16*)(p + 272) = (bf16)(vv[i].z & 0xffffu); *(LAS bf16*)(p + 340) = (bf16)(vv[i].z >> 16); *(LAS bf16*)(p + 408) = (bf16)(vv[i].w & 0xffffu); *(LAS bf16*)(p + 476) = (bf16)(vv[i].w >> 16); } }
    {   const float QS = 0.08838834764831845f * LOG2E;
        const int sub = lane >> 4, l16 = lane & 15;
        float gq[8], gk[8];
        {   const f32x4 a0 = *(const GAS f32x4*)(a.in[I_QNG] + (size_t)l * 128 + 8 * l16), a1 = *(const GAS f32x4*)(a.in[I_QNG] + (size_t)l * 128 + 8 * l16 + 4);
            const f32x4 b0 = *(const GAS f32x4*)(a.in[I_KNG] + (size_t)l * 128 + 8 * l16), b1 = *(const GAS f32x4*)(a.in[I_KNG] + (size_t)l * 128 + 8 * l16 + 4);
#pragma unroll
            for (int e = 0; e < 4; ++e) { gq[e] = a0[e] * QS; gq[4 + e] = a1[e] * QS; gk[e] = b0[e]; gk[4 + e] = b1[e]; } }
        v4u raw[12];
#pragma unroll
        for (int gi = 0; gi < 12; ++gi) { const int isk = gi / 6, idx = (gi % 6) * 4 + sub, i = idx / 6, h = idx % 6;
            raw[gi] = *(const GAS v4u*)(HZ + (m0 + wave * 4 + i) * NHZ + (isk ? HC_FK : HC_Q) + 128 * h + 8 * l16); }
#pragma unroll
        for (int gi = 0; gi < 12; ++gi) { const int isk = gi / 6, idx = (gi % 6) * 4 + sub, i = idx / 6, h = idx % 6;
            float x[8]; unpack8(raw[gi], x);
            float ssq = 0.f;
#pragma unroll
            for (int e = 0; e < 8; ++e) ssq += x[e] * x[e];
            const float r = __builtin_amdgcn_rsqf(row16_sum(ssq) * (1.0f / 128.0f) + 1e-6f);
            v4u o;
            if (isk) { o.x = pk2(x[0] * r * gk[0], x[1] * r * gk[1]); o.y = pk2(x[2] * r * gk[2], x[3] * r * gk[3]); o.z = pk2(x[4] * r * gk[4], x[5] * r * gk[5]); o.w = pk2(x[6] * r * gk[6], x[7] * r * gk[7]); }
            else { o.x = pk2(x[0] * r * gq[0], x[1] * r * gq[1]); o.y = pk2(x[2] * r * gq[2], x[3] * r * gq[3]); o.z = pk2(x[4] * r * gq[4], x[5] * r * gq[5]); o.w = pk2(x[6] * r * gq[6], x[7] * r * gq[7]); }
            const size_t oo = ((size_t)(b * 6 + h) * SEQ + t0 + wave * 4 + i) * 128 + 8 * l16;
            *(GAS v4u*)((isk ? KF : QF) + oo) = o; } }
    __syncthreads();
#pragma unroll
    for (int j = 0; j < 6; ++j) { const int cidx = tid + 512 * j, d = cidx >> 2, part = cidx & 3; const LAS unsigned* sp = (const LAS unsigned*)(lds + d * 68 + part * 16);
        v4u o; o.x = sp[0]; o.y = sp[1]; o.z = sp[2]; o.w = sp[3];
        *(GAS v4u*)(VT + ((size_t)b * 768 + d) * SEQ + t0 + 8 * part) = o; }
    __syncthreads();
}
__device__ __forceinline__ void fox_bias_unit(const Args& a, int l, int u, LAS unsigned char* lds, int tid, int wave, int lane) {
    const bf16* HZ = (const bf16*)(a.ws + WS_HZ);
    const int b = u / 6, h = u % 6;
    const float fb = a.in[I_FB][l * 6 + h];
    LAS float* wtot = (LAS float*)lds;
    float v[8]; float run = 0.f;
#pragma unroll
    for (int i = 0; i < 8; ++i) { const float x = bf2f(HZ[((size_t)b * SEQ + 8 * tid + i) * NHZ + HC_FF + h]) + fb; run += -softplusf(-x); v[i] = run; }
    float inc = run;
#pragma unroll
    for (int o = 1; o < 64; o <<= 1) { const float t = __shfl_up(inc, o); if (lane >= o) inc += t; }
    if (lane == 63) wtot[wave] = inc;
    __syncthreads();
    float base = inc - run;
    for (int w = 0; w < wave; ++w) base += wtot[w];
    float* bias = (float*)(a.ws + WS_BIAS) + (size_t)u * SEQ + 8 * tid;
#pragma unroll
    for (int i = 0; i < 8; ++i) bias[i] = -(base + v[i]) * LOG2E;
    __syncthreads();
}
#define SWZ(row, chunk) ((row) * 512 + ((((chunk) ^ ((row) & 15))) << 4))
#define SW64(row, chunk) ((row) * 128 + ((((chunk) ^ (((row) >> 1) & 7))) << 4))
constexpr int CL_RT = 0, CL_AT = 8192, CL_BH = 16384, CL_KH = 24576, CL_AAK = 32768, CL_BBT = 40960, CL_KBT = 49152, CL_VT = 57344, CL_ARB = 65536, CL_ARK = 73728,
              CL_XR = 81920  , CL_AABT = 114688  , CL_TOT = 114688,
              CL_W1T = 8192, CL_W2T = 16384  , CL_GT = 131072 + 1024;
__device__ __forceinline__ bf16x8 lds_frag(LAS unsigned char* base, int row, int chunk) { return *(const LAS bf16x8*)(base + SW64(row, chunk)); }

__device__ __forceinline__ void rwkv_chunk_unit(const Args& a, int l, int u, LAS unsigned char* lds, int tid, int wave, int lane) {
    asm volatile("" : "+v"(tid), "+v"(lane));
    const int bh = u >> 6, c = u & 63, b = bh / RH, h = bh % RH;
    const int ch = tid & 63, tq = tid >> 6, fr = lane & 15, fq = lane >> 4;
    const bf16* HZ = (const bf16*)(a.ws + WS_HZ);
    const float* mu = a.in[I_MU] + (size_t)l * 2560;
    const int mb = b * SEQ + 64 * c;
    bf16x8 wfA[8], wfB[8]; float rr[9], kr[9], vr[9];
    {   const bf16* WLT = (const bf16*)(a.ws + WS_WLT) + (size_t)l * RW * 256;
        const bf16* wpA = WLT + (size_t)(64 * h + 16 * (2 * (wave & 1)) + fr) * 256 + 8 * fq; const bf16* wpB = wpA + 16 * 256;
#pragma unroll
        for (int ks = 0; ks < 8; ++ks) { wfA[ks] = *(const GAS bf16x8*)(wpA + 32 * ks); wfB[ks] = *(const GAS bf16x8*)(wpB + 32 * ks); }
        const int m0 = mb + 8 * tq; const bool first = (m0 & (SEQ - 1)) == 0; const bf16* p = HZ + (size_t)(m0 - 1) * NHZ + 64 * h + ch;
        rr[0] = 0.f; kr[0] = 0.f; vr[0] = 0.f; if (!first) { rr[0] = bf2f(p[0]); kr[0] = bf2f(p[768]); vr[0] = bf2f(p[1536]); }
#pragma unroll
        for (int i = 1; i < 9; ++i) { const bf16* q = p + (size_t)i * NHZ; rr[i] = bf2f(q[0]); kr[i] = bf2f(q[768]); vr[i] = bf2f(q[1536]); } }
    {   const int t = tid >> 3, j0 = (tid & 7) * 32; const int m = mb + t; const bool first = (m & (SEQ - 1)) == 0;
        const bool zid = (j0 >= 64 && j0 < 128); const float za = j0 < 64 ? 2.0f : 1.0f, zb = za, zc = j0 < 64 ? -1.0f : 0.0f;
        const bf16* cur = HZ + (size_t)m * NHZ + HC_WD + j0; const bf16* prv = cur - NHZ;
#pragma unroll
        for (int q = 0; q < 4; ++q) { float z[8], zcur[8], zprv[8];
            unpack8(*(const GAS v4u*)(cur + 8 * q), zcur); v4u pw = (v4u){0u, 0u, 0u, 0u}; if (!first) pw = *(const GAS v4u*)(prv + 8 * q); unpack8(pw, zprv);
#pragma unroll
            for (int e = 0; e < 8; ++e) z[e] = zcur[e] + (zprv[e] - zcur[e]) * mu[HC_WD + j0 + 8 * q + e];
#pragma unroll
            for (int e = 0; e < 8; ++e) { const float sg = __builtin_amdgcn_rcpf(1.0f + __expf(-zb * z[e])); z[e] = zid ? z[e] : za * sg + zc; }
            v4u o; o.x = pk2(z[0], z[1]); o.y = pk2(z[2], z[3]); o.z = pk2(z[4], z[5]); o.w = pk2(z[6], z[7]);
            *(LAS v4u*)(lds + SWZ(t, (j0 >> 3) + q)) = o; } }
    __syncthreads();
    {   const int tb = wave >> 1;
        bf16x8 zf[8];
#pragma unroll
        for (int ks = 0; ks < 8; ++ks) zf[ks] = *(const LAS bf16x8*)(lds + SWZ(16 * tb + fr, 4 * ks + fq));
#pragma unroll
        for (int j = 0; j < 2; ++j) { const int cb = 2 * (wave & 1) + j;
            f32x4 aw = (f32x4){0.f, 0.f, 0.f, 0.f}, aa = aw, ag = aw;
#pragma unroll
            for (int ks = 0; ks < 8; ++ks) { const bf16x8 w_ = j ? wfB[ks] : wfA[ks];
                if (ks < 2) aw = __builtin_amdgcn_mfma_f32_16x16x32_bf16(zf[ks], w_, aw, 0, 0, 0);
                else if (ks < 4) aa = __builtin_amdgcn_mfma_f32_16x16x32_bf16(zf[ks], w_, aa, 0, 0, 0);
                else ag = __builtin_amdgcn_mfma_f32_16x16x32_bf16(zf[ks], w_, ag, 0, 0, 0); }
            LAS float* L = (LAS float*)(lds + 32768);
#pragma unroll
            for (int i = 0; i < 4; ++i) { const int o = (16 * tb + 4 * fq + i) * 64 + 16 * cb + fr; L[o] = aw[i]; L[4096 + o] = aa[i]; L[8192 + o] = ag[i]; } } }
    __syncthreads();
    float r[8], lw[8], k[8], v[8], kk[8], bb[8];
    {   const int cc = 64 * h + ch; const int m0 = mb + 8 * tq;
        const float a0 = a.in[I_A0][(size_t)l * RW + cc], w0 = a.in[I_W0][(size_t)l * RW + cc], kkc = a.in[I_KK][(size_t)l * RW + cc], kac = a.in[I_KA][(size_t)l * RW + cc], rkc = a.in[I_RK][(size_t)l * RW + cc];
        const float mr = mu[cc], mk = mu[768 + cc], mv = mu[1536 + cc];
        const LAS float* L = (const LAS float*)(lds + 32768);
        bf16* VBp = (bf16*)(a.ws + WS_VB); bf16* GBp = (bf16*)(a.ws + WS_GB); float* BSp = (float*)(a.ws + WS_BS);
        bf16* vbp = VBp + (size_t)m0 * RW + cc; bf16* gbp = GBp + (size_t)m0 * RW + cc; const LAS float* lp = L + (8 * tq) * 64 + ch;
#pragma unroll
        for (int i = 0; i < 8; ++i) {
            r[i] = rr[i + 1] + (rr[i] - rr[i + 1]) * mr; const float k_ = kr[i + 1] + (kr[i] - kr[i + 1]) * mk; v[i] = vr[i + 1] + (vr[i] - vr[i + 1]) * mv;
            const float aw = lp[0], aa = lp[4096], ag = lp[8192];
            const float av = fast_sigmoid(aa + a0); lw[i] = -__expf(-fast_softplus(-(aw + w0)) - 0.5f);
            const float q_ = k_ * kkc; const float rn = __builtin_amdgcn_rsqf(fmaxf(wave_sum(q_ * q_), 1e-24f));
            kk[i] = q_ * rn; bb[i] = kk[i] * av; k[i] = k_ * (1.0f + (av - 1.0f) * kac);
            const float bs = wave_sum(r[i] * k[i] * rkc);
            *vbp = (bf16)f2bf(v[i]); *gbp = (bf16)f2bf(ag);
            if (ch == 0) BSp[(size_t)(m0 + i) * RH + h] = bs;
            vbp += RW; gbp += RW; lp += 64;
            asm volatile("" : "+v"(vbp), "+v"(gbp)); } }
    float cum[8]; { float run = 0.f;
#pragma unroll
        for (int i = 0; i < 8; ++i) { run += lw[i]; cum[i] = run; }
        ((LAS float*)(lds + CL_TOT))[tq * 64 + ch] = run; }
    __syncthreads();
    float off = 0.f, tot = 0.f;
#pragma unroll
    for (int j = 0; j < 8; ++j) { const float t = ((LAS float*)(lds + CL_TOT))[j * 64 + ch]; tot += t; if (j < tq) off += t; }
    if (tq == 0) ((LAS float*)(lds + CL_GT))[ch] = __expf(tot);
    {   v4u wb, wk, wv;
        unsigned short hb[8], hk[8], hv[8];
#pragma unroll
        for (int i = 0; i < 8; ++i) { const int t = 8 * tq + i; const float cu = off + cum[i];
            const float g = __expf(cu), ge = __expf(cu - lw[i]), ig = __expf(-cu), gc = __expf(tot - cu);
            const float at = -kk[i] * ge;
            const int ro = SW64(t, ch >> 3) + (ch & 7) * 2;
            *(LAS bf16*)(lds + CL_RT + ro) = (bf16)f2bf(r[i] * g);
            *(LAS bf16*)(lds + CL_AT + ro) = (bf16)f2bf(at);
            *(LAS bf16*)(lds + CL_BH + ro) = (bf16)f2bf(bb[i] * ig);
            *(LAS bf16*)(lds + CL_KH + ro) = (bf16)f2bf(k[i] * ig);
            ((LAS float*)(lds + CL_XR))[t * 128 + ch] = at;
            hb[i] = (unsigned short)f2bf(bb[i] * gc); hk[i] = (unsigned short)f2bf(k[i] * gc); hv[i] = (unsigned short)f2bf(v[i]); }
        wb.x = hb[0] | (hb[1] << 16); wb.y = hb[2] | (hb[3] << 16); wb.z = hb[4] | (hb[5] << 16); wb.w = hb[6] | (hb[7] << 16);
        wk.x = hk[0] | (hk[1] << 16); wk.y = hk[2] | (hk[3] << 16); wk.z = hk[4] | (hk[5] << 16); wk.w = hk[6] | (hk[7] << 16);
        wv.x = hv[0] | (hv[1] << 16); wv.y = hv[2] | (hv[3] << 16); wv.z = hv[4] | (hv[5] << 16); wv.w = hv[6] | (hv[7] << 16);
        *(LAS v4u*)(lds + CL_BBT + SW64(ch, tq)) = wb; *(LAS v4u*)(lds + CL_KBT + SW64(ch, tq)) = wk; *(LAS v4u*)(lds + CL_VT + SW64(ch, tq)) = wv; }
    __syncthreads();
    {   const int mat = wave & 3;
        LAS unsigned char* X = lds + ((mat < 2) ? CL_AT : CL_RT); LAS unsigned char* Yo = lds + ((mat & 1) ? CL_KH : CL_BH);
        LAS unsigned char* Out = lds + (mat == 1 ? CL_AAK : (mat == 2 ? CL_ARB : CL_ARK));
#pragma unroll
        for (int rbi = 0; rbi < 2; ++rbi) { const int rb = 2 * (wave >> 2) + rbi;
            const bf16x8 x0 = lds_frag(X, 16 * rb + fr, fq), x1 = lds_frag(X, 16 * rb + fr, 4 + fq);
#pragma unroll
            for (int cb = 0; cb < 4; ++cb) {
                f32x4 acc = (f32x4){0.f, 0.f, 0.f, 0.f};
                if (cb <= rb) { acc = __builtin_amdgcn_mfma_f32_16x16x32_bf16(x0, lds_frag(Yo, 16 * cb + fr, fq), acc, 0, 0, 0);
                                acc = __builtin_amdgcn_mfma_f32_16x16x32_bf16(x1, lds_frag(Yo, 16 * cb + fr, 4 + fq), acc, 0, 0, 0); }
                const int sidx = 16 * cb + fr;
#pragma unroll
                for (int i = 0; i < 4; ++i) { const int t = 16 * rb + 4 * fq + i; const bool keep = (mat < 2) ? (sidx < t) : (sidx <= t); const float val = keep ? acc[i] : 0.f;
                    if (mat == 0) ((LAS float*)(lds + CL_AABT))[sidx * 64 + t] = val;
                    else *(LAS bf16*)(Out + SW64(t, sidx >> 3) + (sidx & 7) * 2) = (bf16)f2bf(val); } } } }
    __syncthreads();
    {   const int tb = wave >> 1;
        const bf16x8 x0 = lds_frag(lds + CL_AAK, 16 * tb + fr, fq), x1 = lds_frag(lds + CL_AAK, 16 * tb + fr, 4 + fq);
#pragma unroll
        for (int j = 0; j < 2; ++j) { const int vb = 2 * (wave & 1) + j; f32x4 acc = (f32x4){0.f, 0.f, 0.f, 0.f};
            acc = __builtin_amdgcn_mfma_f32_16x16x32_bf16(x0, lds_frag(lds + CL_VT, 16 * vb + fr, fq), acc, 0, 0, 0);
            acc = __builtin_amdgcn_mfma_f32_16x16x32_bf16(x1, lds_frag(lds + CL_VT, 16 * vb + fr, 4 + fq), acc, 0, 0, 0);
#pragma unroll
            for (int i = 0; i < 4; ++i) ((LAS float*)(lds + CL_XR))[(16 * tb + 4 * fq + i) * 128 + 64 + 16 * vb + fr] = acc[i]; } }
    __syncthreads();
    {   const LAS float* At = (const LAS float*)(lds + CL_AABT);
        LAS unsigned char* scr = lds + CL_KH + wave * 2048;
        bf16x8 tf[4];
        {   const int tb_ = lane >> 4, j = lane & 15; const LAS float* Ab = At + (16 * tb_) * 64 + 16 * tb_;
            float T[16];
#pragma unroll
            for (int t = 0; t < 16; ++t) { float acc = (t == j) ? 1.0f : 0.0f;
#pragma unroll
                for (int sI = 0; sI < t; ++sI) acc += Ab[sI * 64 + t] * T[sI];
                T[t] = acc; if ((t & 3) == 3) __builtin_amdgcn_sched_barrier(0); }
#pragma unroll
            for (int t = 0; t < 16; ++t) *(LAS bf16*)(scr + tb_ * 512 + t * 32 + j * 2) = (bf16)f2bf(T[t]);
            LDS_WAIT(); asm volatile("" ::: "memory");
#pragma unroll
            for (int b4 = 0; b4 < 4; ++b4) { v4u z4 = (v4u){0u, 0u, 0u, 0u}; if (fq < 2) z4 = *(const LAS v4u*)(scr + b4 * 512 + fr * 32 + fq * 16); tf[b4] = __builtin_bit_cast(bf16x8, z4); }
            LDS_WAIT(); asm volatile("" ::: "memory"); }
        const int ncol = 16 * wave + fr;
        LAS unsigned char* Wt = lds + (wave < 4 ? CL_W1T : CL_W2T); const int nrow = (ncol & 63);
        const LAS float* XRp = (const LAS float*)(lds + CL_XR) + ncol;
#pragma unroll
        for (int b4 = 0; b4 < 4; ++b4) {
            f32x4 acc;
#pragma unroll
            for (int i = 0; i < 4; ++i) acc[i] = XRp[(16 * b4 + 4 * fq + i) * 128];
#pragma unroll
            for (int ks = 0; ks < 2; ++ks) if (32 * ks < 16 * b4) {
                float av[8];
#pragma unroll
                for (int e = 0; e < 8; ++e) { const int sI = 32 * ks + 8 * fq + e; av[e] = (sI < 16 * b4) ? At[sI * 64 + 16 * b4 + fr] : 0.f; }
                v4u aw; aw.x = pk2(av[0], av[1]); aw.y = pk2(av[2], av[3]); aw.z = pk2(av[4], av[5]); aw.w = pk2(av[6], av[7]);
                const bf16x8 xf = *(const LAS bf16x8*)(Wt + SW64(nrow, 4 * ks + fq));
                v4u xm = __builtin_bit_cast(v4u, xf);
                if (32 * ks + 8 * fq >= 16 * b4) xm = (v4u){0u, 0u, 0u, 0u};
                acc = __builtin_amdgcn_mfma_f32_16x16x32_bf16(__builtin_bit_cast(bf16x8, aw), __builtin_bit_cast(bf16x8, xm), acc, 0, 0, 0); }
#pragma unroll
            for (int i = 0; i < 4; ++i) *(LAS bf16*)(scr + fr * 32 + (4 * fq + i) * 2) = (bf16)f2bf(acc[i]);
            LDS_WAIT(); asm volatile("" ::: "memory");
            v4u rz = (v4u){0u, 0u, 0u, 0u}; if (fq < 2) rz = *(const LAS v4u*)(scr + fr * 32 + fq * 16);
            LDS_WAIT(); asm volatile("" ::: "memory");
            f32x4 xb = __builtin_amdgcn_mfma_f32_16x16x32_bf16(tf[b4], __builtin_bit_cast(bf16x8, rz), (f32x4){0.f, 0.f, 0.f, 0.f}, 0, 0, 0);
            v2u o; o.x = pk2(xb[0], xb[1]); o.y = pk2(xb[2], xb[3]);
            const int s0 = 16 * b4 + 4 * fq;
            *(LAS v2u*)(Wt + SW64(nrow, s0 >> 3) + (s0 & 7) * 2) = o;
            LDS_WAIT(); asm volatile("" ::: "memory");
            __builtin_amdgcn_sched_barrier(0);
        }
    }
    __syncthreads();
    {   const int job = wave >> 1;
        LAS unsigned char* A1 = lds + (job == 0 ? CL_W1T : job == 1 ? CL_ARB : job == 2 ? CL_W1T : CL_BBT);
        LAS unsigned char* B1 = lds + (job == 0 ? CL_ARB : job == 1 ? CL_W2T : job == 2 ? CL_BBT : CL_W2T);
        LAS unsigned char* A2 = lds + (job == 1 ? CL_ARK : CL_KBT);
        LAS unsigned char* B2 = lds + (job == 1 ? CL_VT : CL_VT);
        unsigned char* ws = a.ws;
#pragma unroll
        for (int rbi = 0; rbi < 2; ++rbi) { const int rb = 2 * (wave & 1) + rbi;
            const bf16x8 x0 = lds_frag(A1, 16 * rb + fr, fq), x1 = lds_frag(A1, 16 * rb + fr, 4 + fq);
            bf16x8 y0 = x0, y1 = x1; if (job & 1) { y0 = lds_frag(A2, 16 * rb + fr, fq); y1 = lds_frag(A2, 16 * rb + fr, 4 + fq); }
#pragma unroll
            for (int cb = 0; cb < 4; ++cb) { f32x4 acc = (f32x4){0.f, 0.f, 0.f, 0.f};
                acc = __builtin_amdgcn_mfma_f32_16x16x32_bf16(x0, lds_frag(B1, 16 * cb + fr, fq), acc, 0, 0, 0);
                acc = __builtin_amdgcn_mfma_f32_16x16x32_bf16(x1, lds_frag(B1, 16 * cb + fr, 4 + fq), acc, 0, 0, 0);
                if (job & 1) { acc = __builtin_amdgcn_mfma_f32_16x16x32_bf16(y0, lds_frag(B2, 16 * cb + fr, fq), acc, 0, 0, 0);
                               acc = __builtin_amdgcn_mfma_f32_16x16x32_bf16(y1, lds_frag(B2, 16 * cb + fr, 4 + fq), acc, 0, 0, 0); }
                if (job == 0) {
                    const int t = 16 * cb + fr, k0 = 16 * rb + 4 * fq; const v2u rt = *(const LAS v2u*)(lds + CL_RT + SW64(t, k0 >> 3) + (k0 & 7) * 2);
                    v2u o; o.x = pk2(acc[0] + __uint_as_float(rt.x << 16), acc[1] + __uint_as_float(rt.x & 0xffff0000u)); o.y = pk2(acc[2] + __uint_as_float(rt.y << 16), acc[3] + __uint_as_float(rt.y & 0xffff0000u));
                    *(GAS v2u*)((bf16*)(ws + WS_CHR2) + ((size_t)u * 64 + t) * 64 + k0) = o;
                } else if (job == 2) {
                    const int kr = 16 * cb + fr, k0 = 16 * rb + 4 * fq; const float gc = ((const LAS float*)(lds + CL_GT))[kr];
                    v2u o; o.x = pk2(acc[0] + (kr == k0 ? gc : 0.f), acc[1] + (kr == k0 + 1 ? gc : 0.f)); o.y = pk2(acc[2] + (kr == k0 + 2 ? gc : 0.f), acc[3] + (kr == k0 + 3 ? gc : 0.f));
                    *(GAS v2u*)((bf16*)(ws + WS_CHP) + ((size_t)u * 64 + kr) * 64 + ((rb >> 1) * 32 + fq * 8 + (rb & 1) * 4)) = o;
                } else {
                    if (job == 1) *(GAS f32x4*)((float*)(ws + WS_CHY0) + (((size_t)u * 4 + rb) * 4 + cb) * 256 + lane * 4) = acc;
                    else *(GAS f32x4*)((float*)(ws + WS_CHQ) + (((size_t)u * 4 + cb) * 4 + rb) * 256 + lane * 4) = acc; } } } }
    __syncthreads();
}
__device__ __forceinline__ void rwkv_state_unit(const Args& a, int bh, int vb, LAS unsigned char* lds, int wave, int lane) {
    if (wave != 0) return;
    const int fr = lane & 15, fq = lane >> 4;
    const bf16* P = (const bf16*)(a.ws + WS_CHP) + (size_t)bh * 64 * 4096; const float* Q = (const float*)(a.ws + WS_CHQ) + (size_t)bh * 64 * 4096; bf16* HS = (bf16*)(a.ws + WS_CHHS) + (size_t)bh * 64 * 4096;
    v4u hB[2]; hB[0] = (v4u){0u, 0u, 0u, 0u}; hB[1] = hB[0];
    bf16x8 pfA[4][2], pfB[4][2], pfC[4][2]; f32x4 qfA[4], qfB[4], qfC[4];
#define ST_LOAD(pf, qf, cc) do { _Pragma("unroll") for (int kb = 0; kb < 4; ++kb) { _Pragma("unroll") for (int ks = 0; ks < 2; ++ks) pf[kb][ks] = *(const GAS bf16x8*)(P + ((size_t)(cc) * 64 + 16 * kb + fr) * 64 + 32 * ks + 8 * fq); \
        qf[kb] = *(const GAS f32x4*)(Q + (((size_t)(cc) * 4 + vb) * 4 + kb) * 256 + lane * 4); } } while (0)
#define ST_STEP(pf, qf, cc) do { \
        _Pragma("unroll") for (int ks = 0; ks < 2; ++ks) { v2u lo_, hi_; lo_.x = hB[ks].x; lo_.y = hB[ks].y; hi_.x = hB[ks].z; hi_.y = hB[ks].w; \
            *(GAS v2u*)(HS + ((size_t)(cc) * 64 + 16 * vb + fr) * 64 + 16 * (2 * ks) + 4 * fq) = lo_; *(GAS v2u*)(HS + ((size_t)(cc) * 64 + 16 * vb + fr) * 64 + 16 * (2 * ks + 1) + 4 * fq) = hi_; } \
        f32x4 acc[4]; \
        _Pragma("unroll") for (int kb = 0; kb < 4; ++kb) { acc[kb] = qf[kb]; \
            _Pragma("unroll") for (int ks = 0; ks < 2; ++ks) acc[kb] = __builtin_amdgcn_mfma_f32_16x16x32_bf16(pf[kb][ks], __builtin_bit_cast(bf16x8, hB[ks]), acc[kb], 0, 0, 0); } \
        ST_LOAD(pf, qf, ((cc) + 3 < 64 ? (cc) + 3 : 63)); \
        _Pragma("unroll") for (int ks = 0; ks < 2; ++ks) { hB[ks].x = pk2(acc[2 * ks][0], acc[2 * ks][1]); hB[ks].y = pk2(acc[2 * ks][2], acc[2 * ks][3]); \
            hB[ks].z = pk2(acc[2 * ks + 1][0], acc[2 * ks + 1][1]); hB[ks].w = pk2(acc[2 * ks + 1][2], acc[2 * ks + 1][3]); } } while (0)
    __builtin_amdgcn_s_waitcnt(0);
    ST_LOAD(pfA, qfA, 0); ST_LOAD(pfB, qfB, 1); ST_LOAD(pfC, qfC, 2);
#pragma unroll 1
    for (int c = 0; c < 63; c += 3) { ST_STEP(pfA, qfA, c); ST_STEP(pfB, qfB, c + 1); ST_STEP(pfC, qfC, c + 2); }
    {   _Pragma("unroll") for (int ks = 0; ks < 2; ++ks) { v2u lo_, hi_; lo_.x = hB[ks].x; lo_.y = hB[ks].y; hi_.x = hB[ks].z; hi_.y = hB[ks].w;
            *(GAS v2u*)(HS + ((size_t)63 * 64 + 16 * vb + fr) * 64 + 16 * (2 * ks) + 4 * fq) = lo_; *(GAS v2u*)(HS + ((size_t)63 * 64 + 16 * vb + fr) * 64 + 16 * (2 * ks + 1) + 4 * fq) = hi_; } }
#undef ST_LOAD
#undef ST_STEP
}
__device__ __forceinline__ void rwkv_out_pass(const Args& a, int l, int gw, int ngw, int lane) {
    const int fr = lane & 15, fq = lane >> 4;
    const bf16* VBp = (const bf16*)(a.ws + WS_VB); const bf16* GBp = (const bf16*)(a.ws + WS_GB); const float* BSp = (const float*)(a.ws + WS_BS); bf16* OB = (bf16*)(a.ws + WS_OB);
    for (int it = gw; it < 1536 * 4; it += ngw) { const int u = it >> 2, tb = it & 3, bh = u >> 6, c = u & 63, b = bh / RH, h = bh % RH;
        const bf16* R2 = (const bf16*)(a.ws + WS_CHR2) + (size_t)u * 4096; const bf16* HS = (const bf16*)(a.ws + WS_CHHS) + (size_t)u * 4096; const float* Y0 = (const float*)(a.ws + WS_CHY0) + ((size_t)u * 4 + tb) * 1024;
        const bf16x8 r0 = *(const GAS bf16x8*)(R2 + (16 * tb + fr) * 64 + 8 * fq), r1 = *(const GAS bf16x8*)(R2 + (16 * tb + fr) * 64 + 32 + 8 * fq);
        const int m0 = b * SEQ + 64 * c + 16 * tb + 4 * fq;
        f32x4 y[4]; bf16x8 hf[4][2]; bf16 vv_[4][4], gg_[4][4]; float bs_[4];
#pragma unroll
        for (int vb = 0; vb < 4; ++vb) { y[vb] = *(const GAS f32x4*)(Y0 + vb * 256 + lane * 4); hf[vb][0] = *(const GAS bf16x8*)(HS + (16 * vb + fr) * 64 + 8 * fq); hf[vb][1] = *(const GAS bf16x8*)(HS + (16 * vb + fr) * 64 + 32 + 8 * fq); }
#pragma unroll
        for (int i = 0; i < 4; ++i) { bs_[i] = BSp[(size_t)(m0 + i) * RH + h];
#pragma unroll
            for (int vb = 0; vb < 4; ++vb) { const size_t o = (size_t)(m0 + i) * RW + 64 * h + 16 * vb + fr; vv_[i][vb] = VBp[o]; gg_[i][vb] = GBp[o]; } }
#pragma unroll
        for (int vb = 0; vb < 4; ++vb) { y[vb] = __builtin_amdgcn_mfma_f32_16x16x32_bf16(r0, hf[vb][0], y[vb], 0, 0, 0); y[vb] = __builtin_amdgcn_mfma_f32_16x16x32_bf16(r1, hf[vb][1], y[vb], 0, 0, 0); }
        float lg[4], lb[4];
#pragma unroll
        for (int vb = 0; vb < 4; ++vb) { lg[vb] = a.in[I_LNXG][(size_t)l * RW + 64 * h + 16 * vb + fr]; lb[vb] = a.in[I_LNXB][(size_t)l * RW + 64 * h + 16 * vb + fr]; }
#pragma unroll
        for (int i = 0; i < 4; ++i) { const int m = m0 + i;
            const float mu = row16_sum((y[0][i] + y[1][i]) + (y[2][i] + y[3][i])) * (1.0f / 64.0f);
            float d[4]; float q = 0.f;
#pragma unroll
            for (int vb = 0; vb < 4; ++vb) { d[vb] = y[vb][i] - mu; q += d[vb] * d[vb]; }
            const float rstd = __builtin_amdgcn_rsqf(row16_sum(q) * (1.0f / 64.0f) + 64e-5f);
#pragma unroll
            for (int vb = 0; vb < 4; ++vb) { const float vv = __uint_as_float(((unsigned)vv_[i][vb]) << 16), gg = __uint_as_float(((unsigned)gg_[i][vb]) << 16);
                OB[(size_t)m * D + 64 * h + 16 * vb + fr] = (bf16)f2bf((d[vb] * rstd * lg[vb] + lb[vb] + bs_[i] * vv) * gg); } } }
}
__device__ __forceinline__ void rwkv_post(const Args& a, int l, int gw, int ngw, int lane) {
    const bf16* VBp = (const bf16*)(a.ws + WS_VB); const bf16* GBp = (const bf16*)(a.ws + WS_GB); const float* BSp = (const float*)(a.ws + WS_BS);
    const float* Y = (const float*)(a.ws + WS_Y); bf16* OB = (bf16*)(a.ws + WS_OB);
    for (int i = gw; i < M * RH; i += ngw) { const int m = i / RH, h = i % RH; const int c = 64 * h + lane; const size_t o = (size_t)m * RW + c;
        const float y = Y[o]; const float mu = wave_sum(y) * (1.0f / 64.0f); const float d = y - mu; const float var = wave_sum(d * d) * (1.0f / 64.0f);
        const float yn = d * __builtin_amdgcn_rsqf(var + 64e-5f) * a.in[I_LNXG][(size_t)l * RW + c] + a.in[I_LNXB][(size_t)l * RW + c];
        const float bs = BSp[i], vv = __uint_as_float(((unsigned)VBp[o]) << 16), gg = __uint_as_float(((unsigned)GBp[o]) << 16);
        OB[(size_t)m * D + c] = (bf16)f2bf((yn + bs * vv) * gg); }
}

__device__ __forceinline__ void attn_tile(const LAS unsigned char* Kt, const LAS unsigned char* Vt, const f32x4 (&bv)[4], const bf16x8 (&qf)[4], f32x4 (&o)[8], float& mrun, float& lsum,
                                          int kt, int row, int rowmin, int fr, int fq) {
    f32x4 sc[4];
#define AT_KF(dst, kb) do { _Pragma("unroll") for (int ks = 0; ks < 4; ++ks) dst[ks] = *(const LAS bf16x8*)(Kt + (16 * (kb) + fr) * 256 + (((4 * ks + fq) ^ fr) << 4)); } while (0)
    {   bf16x8 kfa[4], kfb[4];
        AT_KF(kfa, 0); AT_KF(kfb, 1);
        __builtin_amdgcn_sched_barrier(0);
#pragma unroll
        for (int ks = 0; ks < 4; ++ks) sc[0] = __builtin_amdgcn_mfma_f32_16x16x32_bf16(kfa[ks], qf[ks], ks ? sc[0] : (f32x4){0.f, 0.f, 0.f, 0.f}, 0, 0, 0);
        __builtin_amdgcn_sched_barrier(0);
        AT_KF(kfa, 2);
        __builtin_amdgcn_sched_barrier(0);
#pragma unroll
        for (int ks = 0; ks < 4; ++ks) sc[1] = __builtin_amdgcn_mfma_f32_16x16x32_bf16(kfb[ks], qf[ks], ks ? sc[1] : (f32x4){0.f, 0.f, 0.f, 0.f}, 0, 0, 0);
        __builtin_amdgcn_sched_barrier(0);
        AT_KF(kfb, 3);
        __builtin_amdgcn_sched_barrier(0);
#pragma unroll
        for (int ks = 0; ks < 4; ++ks) sc[2] = __builtin_amdgcn_mfma_f32_16x16x32_bf16(kfa[ks], qf[ks], ks ? sc[2] : (f32x4){0.f, 0.f, 0.f, 0.f}, 0, 0, 0);
#pragma unroll
        for (int ks = 0; ks < 4; ++ks) sc[3] = __builtin_amdgcn_mfma_f32_16x16x32_bf16(kfb[ks], qf[ks], ks ? sc[3] : (f32x4){0.f, 0.f, 0.f, 0.f}, 0, 0, 0);
        __builtin_amdgcn_sched_barrier(0); }
#undef AT_KF
    const bool diag = (64 * kt + 63 > rowmin);
    float mx = -3.0e38f;
#pragma unroll
    for (int kb = 0; kb < 4; ++kb) { const int j0 = 64 * kt + 32 * (kb >> 1) + 8 * fq + 4 * (kb & 1);
#pragma unroll
        for (int i = 0; i < 4; ++i) { float x = sc[kb][i] + bv[kb][i]; if (diag && (j0 + i > row)) x = -__builtin_inff(); sc[kb][i] = x; mx = fmaxf(mx, x); } }
    mx = fmaxf(mx, __shfl_xor(mx, 16)); mx = fmaxf(mx, __shfl_xor(mx, 32));
    const float mnew = fmaxf(mrun, mx), alpha = __builtin_amdgcn_exp2f(mrun - mnew); mrun = mnew;
    float ps = 0.f;
#pragma unroll
    for (int kb = 0; kb < 4; ++kb)
#pragma unroll
        for (int i = 0; i < 4; ++i) { const float p = __builtin_amdgcn_exp2f(sc[kb][i] - mnew); sc[kb][i] = p; ps += p; }
    lsum = lsum * alpha + ps;
    if (__any(alpha != 1.0f)) {
#pragma unroll
        for (int nb = 0; nb < 8; ++nb) o[nb] = o[nb] * alpha; }
    bf16x8 pf[2];
#pragma unroll
    for (int s2 = 0; s2 < 2; ++s2) { v4u w; w.x = pg8::cvt_pk_bf16(sc[2 * s2][0], sc[2 * s2][1]); w.y = pg8::cvt_pk_bf16(sc[2 * s2][2], sc[2 * s2][3]);
        w.z = pg8::cvt_pk_bf16(sc[2 * s2 + 1][0], sc[2 * s2 + 1][1]); w.w = pg8::cvt_pk_bf16(sc[2 * s2 + 1][2], sc[2 * s2 + 1][3]); pf[s2] = __builtin_bit_cast(bf16x8, w); }
#define AT_VF(dst, nb2) do { _Pragma("unroll") for (int j = 0; j < 2; ++j) { _Pragma("unroll") for (int s2 = 0; s2 < 2; ++s2) { const int d = 16 * (2 * (nb2) + j) + fr; \
        dst[j][s2] = *(const LAS bf16x8*)(Vt + d * 128 + (((4 * s2 + fq) ^ ((d >> 1) & 7)) << 4)); } } } while (0)
#define AT_VM(src, nb2) do { _Pragma("unroll") for (int j = 0; j < 2; ++j) { _Pragma("unroll") for (int s2 = 0; s2 < 2; ++s2) o[2 * (nb2) + j] = __builtin_amdgcn_mfma_f32_16x16x32_bf16(src[j][s2], pf[s2], o[2 * (nb2) + j], 0, 0, 0); } } while (0)
    {   bf16x8 vfa[2][2], vfb[2][2];
        AT_VF(vfa, 0); AT_VF(vfb, 1);
        __builtin_amdgcn_sched_barrier(0);
        AT_VM(vfa, 0);
        __builtin_amdgcn_sched_barrier(0);
        AT_VF(vfa, 2);
        __builtin_amdgcn_sched_barrier(0);
        AT_VM(vfb, 1);
        __builtin_amdgcn_sched_barrier(0);
        AT_VF(vfb, 3);
        __builtin_amdgcn_sched_barrier(0);
        AT_VM(vfa, 2); AT_VM(vfb, 3);
        __builtin_amdgcn_sched_barrier(0); }
#undef AT_VF
#undef AT_VM
}
__device__ __forceinline__ void attn_unit(const Args& a, int l, int bh, int qb, LAS unsigned char* lds, int tid, int wave, int lane) {
    const bf16* Q = (const bf16*)(a.ws + WS_QF) + (size_t)bh * SEQ * 128; const bf16* Kg = (const bf16*)(a.ws + WS_KF) + (size_t)bh * SEQ * 128;
    const bf16* VTg = (const bf16*)(a.ws + WS_VT) + (size_t)bh * 128 * SEQ; const float* bias = (const float*)(a.ws + WS_BIAS) + (size_t)bh * SEQ;
    const int fr = lane & 15, fq = lane >> 4, q0 = qb * 128, rowmin = q0 + 16 * wave, row = rowmin + fr;
    bf16x8 qf[4];
#pragma unroll
    for (int ks = 0; ks < 4; ++ks) qf[ks] = *(const bf16x8*)(Q + (size_t)row * 128 + 32 * ks + 8 * fq);
    float sbound;
    {   float q2 = 0.f;
#pragma unroll
        for (int ks = 0; ks < 4; ++ks)
#pragma unroll
            for (int j = 0; j < 8; ++j) { const float x = __uint_as_float(((unsigned)(unsigned short)qf[ks][j]) << 16); q2 += x * x; }
        q2 += __shfl_xor(q2, 16); q2 += __shfl_xor(q2, 32);
        const float qmax = sqrtf(wave_max(q2));
        const float* kg = a.in[I_KNG] + (size_t)l * 128; const float gmax = wave_max(fmaxf(fabsf(kg[2 * lane]), fabsf(kg[2 * lane + 1])));
        sbound = qmax * (11.313708499f * gmax) * 1.02f; }
    f32x4 o[8];
#pragma unroll
    for (int nb = 0; nb < 8; ++nb) o[nb] = (f32x4){0.f, 0.f, 0.f, 0.f};
    float mrun = -1e30f, lsum = 0.f;
    const int nkt = 2 * (qb + 1);
    int kso[2], vso[2]; const bf16* kgp[2]; const bf16* vgp[2];
#pragma unroll
    for (int i = 0; i < 2; ++i) { const int ci = tid + 512 * i;
        { const int kap = ci >> 4, c = ci & 15, kb = 2 * (kap >> 5) + ((kap >> 2) & 1), rho = 4 * ((kap >> 3) & 3) + (kap & 3); kso[i] = (16 * kb + rho) * 256 + ((c ^ rho) << 4); kgp[i] = Kg + (size_t)kap * 128 + 8 * c; }
        { const int d = ci >> 3, c = ci & 7; vso[i] = d * 128 + ((c ^ ((d >> 1) & 7)) << 4); vgp[i] = VTg + (size_t)d * SEQ + 8 * c; } }
    v4u kst[2], vst[2]; f32x4 bvc[4], bvn[4];
#define AT_LOAD(kt) do { _Pragma("unroll") for (int i = 0; i < 2; ++i) { kst[i] = *(const GAS v4u*)(kgp[i] + (size_t)(kt) * 64 * 128); vst[i] = *(const GAS v4u*)(vgp[i] + (kt) * 64); } } while (0)
#define AT_BIAS(dst, kt) do { _Pragma("unroll") for (int kb = 0; kb < 4; ++kb) dst[kb] = *(const GAS f32x4*)(bias + 64 * (kt) + 32 * (kb >> 1) + 8 * fq + 4 * (kb & 1)); } while (0)
#define AT_STORE(s) do { _Pragma("unroll") for (int i = 0; i < 2; ++i) { *(LAS v4u*)(lds + (s) * 32768 + kso[i]) = kst[i]; *(LAS v4u*)(lds + (s) * 32768 + 16384 + vso[i]) = vst[i]; } } while (0)
    volatile LAS unsigned* dfl = (volatile LAS unsigned*)(lds + MISC_OFF + 128);
    AT_LOAD(nkt - 1); AT_BIAS(bvc, nkt - 1); AT_STORE(0);
    __syncthreads();
    bool wdone = false;
#pragma unroll 1
    for (int it = 0, kt = nkt - 1; kt >= 0; ++it, --kt) {
        const int s = it & 1;
        if (kt > 0) { AT_LOAD(kt - 1); AT_BIAS(bvn, kt - 1); }
        __builtin_amdgcn_sched_barrier(0);
        if (!wdone && 64 * kt <= rowmin + 15) attn_tile(lds + s * 32768, lds + s * 32768 + 16384, bvc, qf, o, mrun, lsum, kt, row, rowmin, fr, fq);
        __builtin_amdgcn_sched_barrier(0);
        if (kt > 0) {
            AT_STORE(s ^ 1);
            if (!wdone) { const float bnext = RDL_F(bvn[3][3], 48);
                wdone = (bnext + sbound - wave_min(mrun) < -40.0f); }
#pragma unroll
            for (int kb = 0; kb < 4; ++kb) bvc[kb] = bvn[kb];
        }
        if (lane == 0) dfl[8 * s + wave] = wdone ? 1u : 0u;
        __syncthreads();
        const unsigned all = dfl[8 * s] & dfl[8 * s + 1] & dfl[8 * s + 2] & dfl[8 * s + 3] & dfl[8 * s + 4] & dfl[8 * s + 5] & dfl[8 * s + 6] & dfl[8 * s + 7];
        if (all) break;
    }
#undef AT_LOAD
#undef AT_BIAS
#undef AT_STORE
    __syncthreads();
    lsum += __shfl_xor(lsum, 16); lsum += __shfl_xor(lsum, 32);
    const float inv = 1.0f / lsum;
    bf16* OB = (bf16*)(a.ws + WS_OB);
    const int b = bh / FH, h = bh % FH;
    bf16* dst = OB + ((size_t)b * SEQ + row) * D + 768 + 128 * h + 4 * fq;
#pragma unroll
    for (int nb = 0; nb < 8; ++nb) { v2u w; w.x = pk2(o[nb][0] * inv, o[nb][1] * inv); w.y = pk2(o[nb][2] * inv, o[nb][3] * inv); *(GAS v2u*)(dst + 16 * nb) = w; }
}

struct MoeTiles { int t[9]; };
__device__ __forceinline__ void moe_tile_bases(const Args& a, int& t1, int& t2, int& t3, int& t4, int& t5, int& t6, int& t7, int& t8) {
    unsigned* cnt = (unsigned*)(a.ws + WS_CTL) + CW_CNT;
    int acc = 0;
    acc += ((int)xb_ld(cnt + 64 * 0) + 255) >> 8; t1 = acc; acc += ((int)xb_ld(cnt + 64 * 1) + 255) >> 8; t2 = acc; acc += ((int)xb_ld(cnt + 64 * 2) + 255) >> 8; t3 = acc;
    acc += ((int)xb_ld(cnt + 64 * 3) + 255) >> 8; t4 = acc; acc += ((int)xb_ld(cnt + 64 * 4) + 255) >> 8; t5 = acc; acc += ((int)xb_ld(cnt + 64 * 5) + 255) >> 8; t6 = acc;
    acc += ((int)xb_ld(cnt + 64 * 6) + 255) >> 8; t7 = acc; acc += ((int)xb_ld(cnt + 64 * 7) + 255) >> 8; t8 = acc;
}
__device__ __forceinline__ int moe_sk_full(int t8, int G) { const int total = t8 * 8; int full = (total / G) * G; full -= full % 8; if (total - full > 64) full = total; return full; }
__device__ __forceinline__ void moe_combine(const Args& a, const float* modl, int gw, int ngw, int lane) {
    unsigned char* tk = a.ws + WS_TOK; const bf16* X1 = (const bf16*)(a.ws + WS_X1); const bf16* YB = (const bf16*)(a.ws + WS_YB); const bf16* YB2 = (const bf16*)(a.ws + WS_YB2);
    int t1, t2, t3, t4, t5, t6, t7, t8; moe_tile_bases(a, t1, t2, t3, t4, t5, t6, t7, t8);
    const int rt = (moe_sk_full(t8, (int)gridDim.x) >> 3) * 256;
#define CMB_META(mm, P0_, P1_, G0_, G1_) do { const int e0_ = ((const int*)(tk + TK_EXP))[mm], e1_ = ((const int*)(tk + TK_EXP))[8192 + (mm)]; \
        const int tb0_ = e0_ == 0 ? 0 : (e0_ == 1 ? t1 : e0_ == 2 ? t2 : e0_ == 3 ? t3 : e0_ == 4 ? t4 : e0_ == 5 ? t5 : e0_ == 6 ? t6 : t7); \
        const int tb1_ = e1_ == 0 ? 0 : (e1_ == 1 ? t1 : e1_ == 2 ? t2 : e1_ == 3 ? t3 : e1_ == 4 ? t4 : e1_ == 5 ? t5 : e1_ == 6 ? t6 : t7); \
        P0_ = tb0_ * 256 + ((const int*)(tk + TK_RANK))[mm]; P1_ = tb1_ * 256 + ((const int*)(tk + TK_RANK))[8192 + (mm)]; \
        G0_ = ((const float*)(tk + TK_GATE))[mm]; G1_ = ((const float*)(tk + TK_GATE))[8192 + (mm)]; } while (0)
#define CMB_ROWS(mm, P0_, P1_, X_, YA_, YB_) do { const GAS v2u* x_ = (const GAS v2u*)(X1 + (size_t)(mm) * D) + lane; const GAS v2u* y0_ = (const GAS v2u*)(YB + (size_t)(P0_) * D) + lane; \
        const GAS v2u* y1_ = (const GAS v2u*)(YB + (size_t)(P1_) * D) + lane; _Pragma("unroll") for (int j = 0; j < 8; ++j) { X_[j] = x_[64 * j]; YA_[j] = y0_[64 * j]; YB_[j] = y1_[64 * j]; } } while (0)
    const int nrow = (M + ngw - 1) / ngw, m0 = gw * nrow, m1 = (m0 + nrow < M) ? m0 + nrow : M;
    v2u xw[8], ya[8], yb[8]; f32x4 GT[8]; int bcur = -1;
    int p0 = 0, p1 = 0, p0n = 0, p1n = 0; float g0 = 0.f, g1 = 0.f, g0n = 0.f, g1n = 0.f;
    if (m0 < m1) { CMB_META(m0, p0, p1, g0, g1); CMB_ROWS(m0, p0, p1, xw, ya, yb); if (m0 + 1 < m1) CMB_META(m0 + 1, p0n, p1n, g0n, g1n); }
    for (int m = m0; m < m1; ++m) { const int b = m >> 12;
        if (b != bcur) { bcur = b; const f32x4* gt = (const f32x4*)(modl + (size_t)b * NMOD + 5 * D) + lane;
#pragma unroll
            for (int j = 0; j < 8; ++j) GT[j] = gt[64 * j]; }
        v2u xn[8], yan[8], ybn[8]; int p0nn = 0, p1nn = 0; float g0nn = 0.f, g1nn = 0.f;
        if (m + 1 < m1) CMB_ROWS(m + 1, p0n, p1n, xn, yan, ybn);
        if (m + 2 < m1) CMB_META(m + 2, p0nn, p1nn, g0nn, g1nn);
        GAS f32x4* o = (GAS f32x4*)(a.out + (size_t)m * D) + lane;
        f32x4 Y[8];
#pragma unroll
        for (int j = 0; j < 8; ++j) { const f32x4 A = (f32x4){__uint_as_float(ya[j].x << 16), __uint_as_float(ya[j].x & 0xffff0000u), __uint_as_float(ya[j].y << 16), __uint_as_float(ya[j].y & 0xffff0000u)};
            const f32x4 B = (f32x4){__uint_as_float(yb[j].x << 16), __uint_as_float(yb[j].x & 0xffff0000u), __uint_as_float(yb[j].y << 16), __uint_as_float(yb[j].y & 0xffff0000u)};
            Y[j] = A * g0 + B * g1; }
#pragma unroll
        for (int s2 = 0; s2 < 2; ++s2) { const int p = s2 ? p1 : p0; const float gs = s2 ? g1 : g0;
            if (p >= rt) {
#pragma unroll
                for (int q = 0; q < 3; ++q) { const GAS v2u* e = (const GAS v2u*)(YB2 + ((size_t)q * 2048 + (size_t)(p - rt)) * D) + lane; v2u ew[8];
#pragma unroll
                    for (int j = 0; j < 8; ++j) ew[j] = e[64 * j];
#pragma unroll
                    for (int j = 0; j < 8; ++j) Y[j] += (f32x4){__uint_as_float(ew[j].x << 16), __uint_as_float(ew[j].x & 0xffff0000u), __uint_as_float(ew[j].y << 16), __uint_as_float(ew[j].y & 0xffff0000u)} * gs; } } }
#pragma unroll
        for (int j = 0; j < 8; ++j) { const f32x4 X = (f32x4){__uint_as_float(xw[j].x << 16), __uint_as_float(xw[j].x & 0xffff0000u), __uint_as_float(xw[j].y << 16), __uint_as_float(xw[j].y & 0xffff0000u)};
            o[64 * j] = X + GT[j] * Y[j]; }
#pragma unroll
        for (int j = 0; j < 8; ++j) { xw[j] = xn[j]; ya[j] = yan[j]; yb[j] = ybn[j]; }
        p0 = p0n; p1 = p1n; g0 = g0n; g1 = g1n; p0n = p0nn; p1n = p1nn; g0n = g0nn; g1n = g1nn; }
#undef CMB_META
#undef CMB_ROWS
}

constexpr int PPL = 13, NPH = 1 + 2 * PPL;
#ifndef PH_MASK
#define PH_MASK 0xFFFFFFFFu
#endif
#ifndef ONLY_L
#define ONLY_L -1
#endif
#define PHK(k) ((k) == 0 ? 0 : (((k) - 1) % PPL) + 1)
#define IN(k) (((PH_MASK >> PHK(k)) & 1u) && lo <= (k) && (k) < hi)
#define GRID_BAR() xcd_barrier(bar)
#define SEAM(k) do { if (lo <= (k) && (k) + 1 < hi) GRID_BAR(); } while (0)
#ifndef PROBE_REP_MASK
#define PROBE_REP_MASK 0u
#endif
#define REPQ(q) (((PROBE_REP_MASK) >> (q)) & 1u)
#ifndef PROBE_PREP_X
#define PROBE_PREP_X 1
#endif


#ifdef DBG_TRACE
__device__ __forceinline__ void trace_f32(const Args& a, const float* p, size_t n, int slot, int G, int tid) {
    unsigned bad = 0; for (size_t i = (size_t)blockIdx.x * NT + tid; i < n; i += (size_t)G * NT) { const float v = fabsf(p[i]); if (!(v < 1e6f)) bad = 1; }
    if (bad) atomicOr((unsigned*)(a.ws + WS_CTL) + 40000 + slot, 1u); }
__device__ __forceinline__ void trace_bf16(const Args& a, const bf16* p, size_t n, int slot, int G, int tid) {
    unsigned bad = 0; for (size_t i = (size_t)blockIdx.x * NT + tid; i < n; i += (size_t)G * NT) { const float v = fabsf(__uint_as_float(((unsigned)p[i]) << 16)); if (!(v < 1e6f)) bad = 1; }
    if (bad) atomicOr((unsigned*)(a.ws + WS_CTL) + 40000 + slot, 1u); }
#define TRACE_F32(p, n, slot) trace_f32(a, (const float*)(p), (size_t)(n), (slot), G, tid)
#define TRACE_BF16(p, n, slot) trace_bf16(a, (const bf16*)(p), (size_t)(n), (slot), G, tid)
#else
#define TRACE_F32(p, n, slot) do { } while (0)
#define TRACE_BF16(p, n, slot) do { } while (0)
#endif
template <int L>
__device__ __forceinline__ void layer_phases(const Args& a, LAS unsigned char* lds, const XcdBarrier& bar, int lo, int hi, int tid, int lane, int wave, int G, int gw, int ngw) {
    constexpr int l = L, pb = 1 + PPL * L;
    float* MOD = (float*)(a.ws + WS_MOD);
    bf16* HB = (bf16*)(a.ws + WS_HB); bf16* OB = (bf16*)(a.ws + WS_OB); float* X1 = (float*)(a.ws + WS_X1); float* HZ = (float*)(a.ws + WS_HZ);
    bf16* ACT = (bf16*)(a.ws + WS_ACT);
    bf16* X1b = (bf16*)(a.ws + WS_X1); bf16* XAb = (bf16*)(a.ws + WS_X1 + 32 * MiB);
    const float* modl = MOD + (size_t)l * 2 * NMOD;
    if (IN(pb + 0)) { if (L == 0) adaln_rows<false, false>(a, a.in[I_X], a.in[I_N1G] + (size_t)l * D, modl, 0, D, HB, gw, ngw, lane);
        else adaln_rows<false, true>(a, XAb, a.in[I_N1G] + (size_t)l * D, modl, 0, D, HB, gw, ngw, lane); }
    SEAM(pb + 0);
    TRACE_BF16(HB, (size_t)M * D, 1 + 16 * L + 0);
    if (IN(pb + 1)) { pg8::Gemm g{HB, (const bf16*)(a.ws + WS_WIN) + (size_t)l * NHZ * D, M, NHZ, D}; pg8::StaticOrder S; S.init(M, NHZ, G, (int)blockIdx.x);
        pg8::EpiBf16 E{(bf16*)HZ, NHZ, 1 << 20}; pg8::gemm_phase<pg8::EpiBf16, pg8::StaticOrder, true, true>(lds, g, S, E); }
    SEAM(pb + 1);
    TRACE_F32(HZ, (size_t)M * NHZ, 1 + 16 * L + 1);
    if (IN(pb + 2)) {
        for (int u = blockIdx.x; u < 1536; u += G) rwkv_chunk_unit(a, l, u, lds, tid, wave, lane);
        for (int u = blockIdx.x; u < 524; u += G) {
            if (u < 256) sgu_unit(a, l, u, lds, tid, wave, lane);
            else if (u < 512) fox_prep_unit(a, l, u - 256, lds, tid, wave, lane);
            else fox_bias_unit(a, l, u - 512, lds, tid, wave, lane);
        }
    }
    if (lo <= pb + 2 && pb + 4 < hi) GRID_BAR();
    if (IN(pb + 4)) for (int rep = 0; rep < 1 + (int)REPQ(4); ++rep) {
        if (rep) GRID_BAR();
        for (int u = blockIdx.x; u < 96; u += G) { rwkv_state_unit(a, u >> 2, u & 3, lds, wave, lane); __syncthreads(); }
        {
            unsigned* ctr = (unsigned*)(a.ws + WS_CTL) + CW_ATQ + 64 * (2 * L + rep);
            volatile LAS unsigned* nxt = (volatile LAS unsigned*)(lds + MISC_OFF + 64);
            for (;;) {
                if (tid == 0) *nxt = xb_add(ctr, 1u);
                __syncthreads();
                const int u = (int)*nxt;
                __syncthreads();
                if (u >= 384) break;
                attn_unit(a, l, u % 12, 31 - u / 12, lds, tid, wave, lane);
            }
        }
    }
    SEAM(pb + 4);
    TRACE_BF16(a.ws + WS_CHHS, (size_t)1536 * 4096, 1 + 16 * L + 5);
#ifdef DBG_TRACE
    {   unsigned bad0 = 0, bad1 = 0, bad2 = 0;
        for (size_t i = (size_t)blockIdx.x * NT + tid; i < (size_t)M * D; i += (size_t)G * NT) { const float v = fabsf(__uint_as_float(((unsigned)OB[i]) << 16)); const int c = (int)(i & 2047);
            if (!(v < 1e6f)) { if (c < 768) bad0 = 1; else if (c < 1536) bad1 = 1; else bad2 = 1; } }
        unsigned* sl = (unsigned*)(a.ws + WS_CTL) + 40000 + 1 + 16 * L;
        if (bad0) atomicOr(sl + 15, 1u); if (bad2) atomicOr(sl + 15, 1u); if (bad1) atomicOr(sl + 6, 1u); }
#endif
    if (IN(pb + 5)) rwkv_out_pass(a, l, gw, ngw, lane);
    if (lo <= pb + 5 && pb + 7 < hi) GRID_BAR();
    TRACE_F32(a.ws + WS_Y, (size_t)M * RW, 1 + 16 * L + 6);
#ifdef DBG_TRACE
    {   unsigned bad0 = 0, bad1 = 0, bad2 = 0;
        for (size_t i = (size_t)blockIdx.x * NT + tid; i < (size_t)M * D; i += (size_t)G * NT) { const float v = fabsf(__uint_as_float(((unsigned)OB[i]) << 16)); const int c = (int)(i & 2047);
            if (!(v < 1e6f)) { if (c < 768) bad0 = 1; else if (c < 1536) bad1 = 1; else bad2 = 1; } }
        unsigned* sl = (unsigned*)(a.ws + WS_CTL) + 40000 + 1 + 16 * L;
        if (bad0) atomicOr(sl + 7, 1u); if (bad1) atomicOr(sl + 9, 1u); if (bad2) atomicOr(sl + 10, 1u); }
#endif
    if (IN(pb + 7)) { pg8::Gemm g{OB, (const bf16*)(a.ws + WS_WOUT) + (size_t)l * D * D, M, D, D}; pg8::StaticOrder S; S.init(M, D, G, (int)blockIdx.x);
        if constexpr (L == 0) { pg8::EpiResB<false> E{a.in[I_X], X1b, modl + 2 * D, NMOD}; pg8::gemm_phase<pg8::EpiResB<false>, pg8::StaticOrder, true, true>(lds, g, S, E); }
        else { pg8::EpiResB<true> E{XAb, X1b, modl + 2 * D, NMOD}; pg8::gemm_phase<pg8::EpiResB<true>, pg8::StaticOrder, true, true>(lds, g, S, E); } }
    SEAM(pb + 7);
    TRACE_F32(X1, (size_t)M * D, 1 + 16 * L + 11);
    if constexpr (L == 0) {
        if (IN(pb + 8)) adaln_rows<false, true>(a, X1b, a.in[I_N2G] + (size_t)l * D, modl, 3 * D, 4 * D, HB, gw, ngw, lane);
        if (lo <= pb + 8 && pb + 10 < hi) GRID_BAR();
        if (IN(pb + 10)) { pg8::Gemm g{HB, (const bf16*)(a.ws + WS_W13), M, 2 * DFF, D}; pg8::StaticOrder S; S.init(M, 2 * DFF, G, (int)blockIdx.x);
            pg8::EpiSwiGLU E{ACT, DFF, 44}; pg8::gemm_phase<pg8::EpiSwiGLU, pg8::StaticOrder, true, true>(lds, g, S, E); }
        SEAM(pb + 10);
        if (IN(pb + 11)) { pg8::Gemm g{ACT, (const bf16*)(a.ws + WS_W2T), M, D, DFF}; pg8::StaticOrder S; S.init(M, D, G, (int)blockIdx.x);
            pg8::EpiResB<true> E{X1b, XAb, modl + 5 * D, NMOD}; pg8::gemm_phase<pg8::EpiResB<true>, pg8::StaticOrder, true, true>(lds, g, S, E); }
        if (lo <= pb + 11 && pb + 13 < hi) GRID_BAR();
    } else {
        if (IN(pb + 8)) adaln_rows<true, true>(a, X1b, a.in[I_N2G] + (size_t)l * D, modl, 3 * D, 4 * D, (bf16*)(a.ws + WS_HS), gw, ngw, lane, lds, tid);
        if (lo <= pb + 8 && pb + 10 < hi) GRID_BAR();
        if (IN(pb + 10)) { pg8::MoeOrder S; moe_tile_bases(a, S.t1, S.t2, S.t3, S.t4, S.t5, S.t6, S.t7, S.t8); S.ncol = 22; S.G = G; S.c = (int)blockIdx.x;
            pg8::Gemm g{(const bf16*)(a.ws + WS_HS), (const bf16*)(a.ws + WS_MW13), MOE_ROWS, 8 * DFF, D};
            pg8::EpiSwiGLU E{ACT, DFE, 22}; pg8::gemm_phase<pg8::EpiSwiGLU, pg8::MoeOrder, true, true>(lds, g, S, E); }
        SEAM(pb + 10);
        if (IN(pb + 11)) { pg8::MoeOrderSK S; moe_tile_bases(a, S.t1, S.t2, S.t3, S.t4, S.t5, S.t6, S.t7, S.t8); S.ncol = 8; S.G = G; S.c = (int)blockIdx.x; S.full = moe_sk_full(S.t8, G);
            pg8::Gemm g{ACT, (const bf16*)(a.ws + WS_MW2T), MOE_ROWS, 8 * D, DFE};
            pg8::EpiBf16SK E{(bf16*)(a.ws + WS_YB), (bf16*)(a.ws + WS_YB2), D, 8, (S.full >> 3) * 256}; pg8::gemm_phase<pg8::EpiBf16SK, pg8::MoeOrderSK, true, true>(lds, g, S, E); }
        SEAM(pb + 11);
        if (IN(pb + 12)) moe_combine(a, modl, gw, ngw, lane);
    }
}

__global__ void __launch_bounds__(NT, 2) fwd_kernel(Args a) {
    extern __shared__ __attribute__((aligned(16))) unsigned char lds_raw[];
    LAS unsigned char* lds = (LAS unsigned char*)lds_raw;
    const int tid = threadIdx.x, lane = tid & 63, wave = __builtin_amdgcn_readfirstlane(tid >> 6);
    const int G = gridDim.x, gw = blockIdx.x * NWAVES + wave, ngw = G * NWAVES;
    volatile LAS unsigned* MISC = (volatile LAS unsigned*)(lds + MISC_OFF);
    for (int u = tid; u < (LDS_BYTES - 131072) / 4; u += NT) ((LAS unsigned*)(lds + 131072))[u] = 0u;
    __syncthreads();
    const int lo = a.ph_lo, hi = a.ph_hi;
    XcdBarrier bar = xcd_barrier_post((unsigned*)(a.ws + WS_CTL) + CW_BAR, MISC + 8);
    if (IN(0)) { if (blockIdx.x == 0 && tid < 8) ((unsigned*)(a.ws + WS_CTL))[CW_CNT + 64 * tid] = 0u;
        p0_mod(a, lds, tid, wave, lane); p0_convert(a, lds, gw, ngw, wave, lane); }
    SEAM(0);
#ifdef DBG_TRACE
    trace_bf16(a, (const bf16*)(a.ws + WS_WIN), (size_t)394 * MiB / 2, 39, G, tid); trace_f32(a, (const float*)(a.ws + WS_MOD), 4 * NMOD, 39, G, tid);
#endif
    if (ONLY_L < 0 || ONLY_L == 0) layer_phases<0>(a, lds, bar, lo, hi, tid, lane, wave, G, gw, ngw);
    if (ONLY_L < 0 || ONLY_L == 1) layer_phases<1>(a, lds, bar, lo, hi, tid, lane, wave, G, gw, ngw);
#ifdef DBG_TRACE
    {   unsigned* slots = (unsigned*)(a.ws + WS_CTL) + 40000;
        GRID_BAR();
        for (size_t i = (size_t)blockIdx.x * NT + tid; i < (size_t)M * D; i += (size_t)G * NT) a.out[i] = a.in[I_X][i];
        GRID_BAR();
        if (blockIdx.x == 0 && tid == 0) { unsigned c = 0; const int order[16] = {0, 1, 2, 12, 13, 14, 3, 4, 5, 15, 6, 7, 9, 10, 11, 8};
            if (xb_ld(slots + 39)) c = 1;
            if (xb_ld(slots + 38)) { a.out[0] = (10.0f + 0.5f * (float)(xb_ld(slots + 38) & 127u)) * 100.0f; return; }
            for (int L2 = 0; L2 < 2 && !c; ++L2) for (int j = 0; j < 16; ++j) if (xb_ld(slots + 1 + 16 * L2 + order[j])) { c = 2 + 16 * L2 + j; break; }
            a.out[0] = (10.0f + (float)c) * 100.0f; }
    }
#endif
}
#undef IN
#undef SEAM

extern "C" void kernel_launch(void* const* d_in, const int* in_sizes, int n_in, void* d_out, int out_size, void* d_ws, size_t ws_size, hipStream_t stream) {
    static int grid = 0;
    if (grid == 0) {
        if (n_in != 34 || out_size != M * D || ws_size < WS_END) { fprintf(stderr, "kernel_launch: unexpected shapes (n_in %d out %d ws %zu need %zu)\n", n_in, out_size, ws_size, (size_t)WS_END); grid = -1; return; }
        int dev = 0, cus = 0, per_cu = 0;
        if (hipGetDevice(&dev) != hipSuccess || hipDeviceGetAttribute(&cus, hipDeviceAttributeMultiprocessorCount, dev) != hipSuccess) { grid = -1; return; }
        if (hipFuncSetAttribute((const void*)fwd_kernel, hipFuncAttributeMaxDynamicSharedMemorySize, LDS_BYTES) != hipSuccess) { fprintf(stderr, "kernel_launch: hipFuncSetAttribute failed\n"); grid = -1; return; }
        if (hipOccupancyMaxActiveBlocksPerMultiprocessor(&per_cu, (const void*)fwd_kernel, NT, LDS_BYTES) != hipSuccess || per_cu < 1) { fprintf(stderr, "kernel_launch: occupancy query says %d\n", per_cu); }
        (void)hipGetLastError();
        grid = cus;
    }
    if (grid < 0) return;
    (void)hipMemsetAsync((char*)d_ws + WS_CTL, 0, CTL_ZERO_BYTES, stream);
    Args a{};
    for (int i = 0; i < 34; ++i) a.in[i] = (const float*)d_in[i];
    a.out = (float*)d_out; a.ws = (unsigned char*)d_ws;
    a.ph_lo = 0; a.ph_hi = NPH;
    hipLaunchKernelGGL(fwd_kernel, dim3(grid), dim3(NT), LDS_BYTES, stream, a);
}
```

```cpp
#include <hip/hip_runtime.h>
#include <cstdio>
#include <cstdint>


namespace pg8 {
#define PG8_LAS __attribute__((address_space(3)))
typedef unsigned short bf16_t;
typedef short bf16x8 __attribute__((ext_vector_type(8)));
typedef float f32x4 __attribute__((ext_vector_type(4)));
typedef unsigned u32x4 __attribute__((ext_vector_type(4)));
constexpr int BM = 256, BK = 64, HALF = 128, HTB = HALF * BK * 2, STAGE_BYTES = 8 * HTB, NXCD = 8, WGM = 4;

__host__ __device__ __forceinline__ int lds_byte(int r, int c) { const int st = (r >> 4) * 2 + (c >> 5), rr = r & 15, cc = c & 31, ob = rr * 64 + cc * 2; return st * 1024 + (ob ^ (((ob >> 9) & 1) << 5)); }
__host__ __device__ __forceinline__ void stage_rc(int b, int& R, int& C) { const int st = b / 1024, sb = b % 1024, swz = sb ^ (((sb >> 9) & 1) << 5); R = (st >> 1) * 16 + swz / 64; C = (st & 1) * 32 + (swz % 64) / 2; }
__host__ __device__ __forceinline__ int perm32(int rho) { const int n = rho >> 4, i = rho & 15; return 8 * (i >> 2) + 4 * n + (i & 3); }

struct Unit { int pm, pn; int kofs = 0, nt = 0, part = 0, pa = 0; };
struct Gemm { const bf16_t* A; const bf16_t* Bt; int M, N, K; int ld = 0; };

struct StaticOrder {
    static constexpr bool SPLITK = false, APA = false;
    int nM, nN, nwg, G, c;
    __host__ __device__ void init(int M, int N, int G_, int c_) { nM = M / BM; nN = N / BM; nwg = nM * nN; G = G_; c = c_; }
    __host__ __device__ bool next(int i, Unit& u) const {
        const long L = (long)i * G + c; if (L >= nwg) return false;
        int wgid = (int)L; { const int q = nwg / NXCD, r = nwg % NXCD, xcd = wgid % NXCD, off = wgid / NXCD; wgid = (xcd < r ? xcd * (q + 1) : r * (q + 1) + (xcd - r) * q) + off; }
        const int nig = WGM * nN, gid = wgid / nig, fm = gid * WGM, gsz = (nM - fm) < WGM ? (nM - fm) : WGM;
        u.pm = fm + ((wgid % nig) % gsz); u.pn = (wgid % nig) / gsz; return true;
    }
    __device__ __forceinline__ void a_ready(const Unit&) const {}
    __device__ __forceinline__ void done(const Unit&) const {}
};
struct MoeOrder {
    static constexpr bool SPLITK = false, APA = true;
    int t1, t2, t3, t4, t5, t6, t7, t8, ncol, G, c;
    __device__ __forceinline__ bool next(int i, Unit& u) const {
        const long L = (long)i * G + c; if (L >= (long)t8 * ncol) return false;
        const int T = (int)(L / ncol), j = (int)(L % ncol);
        const int e = (T >= t1) + (T >= t2) + (T >= t3) + (T >= t4) + (T >= t5) + (T >= t6) + (T >= t7);
        const int tb = e == 0 ? 0 : (e == 1 ? t1 : e == 2 ? t2 : e == 3 ? t3 : e == 4 ? t4 : e == 5 ? t5 : e == 6 ? t6 : t7);
        u.pm = T; u.pn = e * ncol + j; u.pa = e * 32 + (T - tb); return true;
    }
    __device__ __forceinline__ void a_ready(const Unit&) const {}
    __device__ __forceinline__ void done(const Unit&) const {}
};

struct MoeOrderSK {
    static constexpr bool SPLITK = true, APA = false;
    int t1, t2, t3, t4, t5, t6, t7, t8, ncol, G, c, full;
    __device__ __forceinline__ bool next(int i, Unit& u) const {
        const long L = (long)i * G + c; const int total = t8 * ncol; int Lu, part;
        if (L < full) { Lu = (int)L; part = 0; u.kofs = 0; u.nt = 44; }
        else { const long sidx = L - full; if (sidx >= (long)(total - full) * 4) return false;
            Lu = full + (int)(sidx >> 2); part = (int)(sidx & 3); u.kofs = (part * 12 - (part == 3 ? 2 : 0)) * BK; u.nt = 12 - 2 * (part >> 1); }
        const int T = Lu / ncol, j = Lu % ncol;
        const int e = (T >= t1) + (T >= t2) + (T >= t3) + (T >= t4) + (T >= t5) + (T >= t6) + (T >= t7);
        u.pm = T; u.pn = e * ncol + j; u.part = part; return true;
    }
    __device__ __forceinline__ void a_ready(const Unit&) const {}
    __device__ __forceinline__ void done(const Unit&) const {}
};

typedef float f32x2_cv __attribute__((ext_vector_type(2)));
typedef __bf16 bf16x2_cv __attribute__((ext_vector_type(2)));
__device__ __forceinline__ unsigned cvt_pk_bf16(float lo, float hi) { const f32x2_cv v = {lo, hi}; return __builtin_bit_cast(unsigned, __builtin_convertvector(v, bf16x2_cv)); }

struct EpiF32 {
    static constexpr bool PERM = false, AFTER_DRAIN = false;
    float* C; int ldc; int pnmod;
    __device__ __forceinline__ void operator()(const f32x4 (&acc)[2][2][4][2], const Unit& u, int wr, int wc, int fr, int fq) const {
        const int row0 = u.pm * BM + wr * 64 + fr, col0 = (u.pn % pnmod) * BM + wc * 32 + 4 * fq;
#pragma unroll
        for (int ai = 0; ai < 2; ++ai)
#pragma unroll
            for (int m = 0; m < 4; ++m) { float* rowp = C + (size_t)(row0 + ai * HALF + m * 16) * ldc + col0;
#pragma unroll
                for (int bj = 0; bj < 2; ++bj)
#pragma unroll
                    for (int n = 0; n < 2; ++n) *(f32x4*)(rowp + bj * HALF + n * 16) = acc[ai][bj][m][n]; }
    }
};
struct EpiBf16 {
    static constexpr bool PERM = true, AFTER_DRAIN = false;
    bf16_t* O; int ldc; int pnmod;
    __device__ __forceinline__ void operator()(const f32x4 (&acc)[2][2][4][2], const Unit& u, int wr, int wc, int fr, int fq) const {
        const int row0 = u.pm * BM + wr * 64 + fr, col0 = (u.pn % pnmod) * BM + wc * 32 + 8 * fq;
#pragma unroll
        for (int ai = 0; ai < 2; ++ai)
#pragma unroll
            for (int m = 0; m < 4; ++m) { bf16_t* rowp = O + (size_t)(row0 + ai * HALF + m * 16) * ldc + col0;
#pragma unroll
                for (int bj = 0; bj < 2; ++bj) { const f32x4 v0 = acc[ai][bj][m][0], v1 = acc[ai][bj][m][1];
                    u32x4 w; w.x = cvt_pk_bf16(v0[0], v0[1]); w.y = cvt_pk_bf16(v0[2], v0[3]); w.z = cvt_pk_bf16(v1[0], v1[1]); w.w = cvt_pk_bf16(v1[2], v1[3]);
                    *(u32x4*)(rowp + bj * HALF) = w; } }
    }
};
struct EpiBf16SK {
    static constexpr bool PERM = true, AFTER_DRAIN = false;
    bf16_t* O; bf16_t* O2; int ldc; int pnmod; int row_t;
    __device__ __forceinline__ void operator()(const f32x4 (&acc)[2][2][4][2], const Unit& u, int wr, int wc, int fr, int fq) const {
        const int row0 = u.pm * BM + wr * 64 + fr, col0 = (u.pn % pnmod) * BM + wc * 32 + 8 * fq;
        bf16_t* Ob = u.part == 0 ? O : O2 + ((long)(u.part - 1) * 2048 - row_t) * (long)ldc;
#pragma unroll
        for (int ai = 0; ai < 2; ++ai)
#pragma unroll
            for (int m = 0; m < 4; ++m) { bf16_t* rowp = Ob + (size_t)(row0 + ai * HALF + m * 16) * ldc + col0;
#pragma unroll
                for (int bj = 0; bj < 2; ++bj) { const f32x4 v0 = acc[ai][bj][m][0], v1 = acc[ai][bj][m][1];
                    u32x4 w; w.x = cvt_pk_bf16(v0[0], v0[1]); w.y = cvt_pk_bf16(v0[2], v0[3]); w.z = cvt_pk_bf16(v1[0], v1[1]); w.w = cvt_pk_bf16(v1[2], v1[3]);
                    *(u32x4*)(rowp + bj * HALF) = w; } }
    }
};
struct EpiRes {
    static constexpr bool PERM = false, AFTER_DRAIN = false;
    const float* xin; float* out; const float* gate; int gstride;
    __device__ __forceinline__ void operator()(const f32x4 (&acc)[2][2][4][2], const Unit& u, int wr, int wc, int fr, int fq) const {
        const int row0 = u.pm * BM + wr * 64 + fr, col0 = u.pn * BM + wc * 32 + 4 * fq;
        const float* gp = gate + (size_t)(u.pm >> 4) * gstride + col0;
        f32x4 gv[2][2];
#pragma unroll
        for (int bj = 0; bj < 2; ++bj)
#pragma unroll
            for (int n = 0; n < 2; ++n) gv[bj][n] = *(const f32x4*)(gp + bj * HALF + n * 16);
#pragma unroll
        for (int ai = 0; ai < 2; ++ai)
#pragma unroll
            for (int m = 0; m < 4; ++m) { const size_t ro = (size_t)(row0 + ai * HALF + m * 16) * 2048 + col0;
#pragma unroll
                for (int bj = 0; bj < 2; ++bj)
#pragma unroll
                    for (int n = 0; n < 2; ++n) { const f32x4 xv = *(const f32x4*)(xin + ro + bj * HALF + n * 16); *(f32x4*)(out + ro + bj * HALF + n * 16) = xv + gv[bj][n] * acc[ai][bj][m][n]; } }
    }
};
template <bool IN_BF16> struct EpiResB {
    static constexpr bool PERM = true, AFTER_DRAIN = false;
    const void* xin; bf16_t* out; const float* gate; int gstride;
    __device__ __forceinline__ void operator()(const f32x4 (&acc)[2][2][4][2], const Unit& u, int wr, int wc, int fr, int fq) const {
        const int row0 = u.pm * BM + wr * 64 + fr, col0 = u.pn * BM + wc * 32 + 8 * fq;
        const float* gp = gate + (size_t)(u.pm >> 4) * gstride + col0;
        f32x4 gv[2][2];
#pragma unroll
        for (int bj = 0; bj < 2; ++bj)
#pragma unroll
            for (int n = 0; n < 2; ++n) gv[bj][n] = *(const f32x4*)(gp + bj * HALF + 4 * n);
#pragma unroll
        for (int ai = 0; ai < 2; ++ai)
#pragma unroll
            for (int m = 0; m < 4; ++m) { const size_t ro = (size_t)(row0 + ai * HALF + m * 16) * 2048 + col0;
#pragma unroll
                for (int bj = 0; bj < 2; ++bj) { f32x4 x0, x1;
                    if (IN_BF16) { const u32x4 w = *(const u32x4*)((const bf16_t*)xin + ro + bj * HALF);
                        x0 = (f32x4){__uint_as_float(w.x << 16), __uint_as_float(w.x & 0xffff0000u), __uint_as_float(w.y << 16), __uint_as_float(w.y & 0xffff0000u)};
                        x1 = (f32x4){__uint_as_float(w.z << 16), __uint_as_float(w.z & 0xffff0000u), __uint_as_float(w.w << 16), __uint_as_float(w.w & 0xffff0000u)}; }
                    else { x0 = *(const f32x4*)((const float*)xin + ro + bj * HALF); x1 = *(const f32x4*)((const float*)xin + ro + bj * HALF + 4); }
                    const f32x4 v0 = x0 + gv[bj][0] * acc[ai][bj][m][0], v1 = x1 + gv[bj][1] * acc[ai][bj][m][1];
                    u32x4 o; o.x = cvt_pk_bf16(v0[0], v0[1]); o.y = cvt_pk_bf16(v0[2], v0[3]); o.z = cvt_pk_bf16(v1[0], v1[1]); o.w = cvt_pk_bf16(v1[2], v1[3]);
                    *(u32x4*)(out + ro + bj * HALF) = o; } }
    }
};
struct EpiSwiGLU {
    static constexpr bool PERM = true, AFTER_DRAIN = false;
    bf16_t* O; int ldc; int ncolmod;
    __device__ __forceinline__ void operator()(const f32x4 (&acc)[2][2][4][2], const Unit& u, int wr, int wc, int fr, int fq) const {
        const int row0 = u.pm * BM + wr * 64 + fr, col0 = (u.pn % ncolmod) * HALF + wc * 32 + 8 * fq;
#pragma unroll
        for (int ai = 0; ai < 2; ++ai)
#pragma unroll
            for (int m = 0; m < 4; ++m) { bf16_t* rowp = O + (size_t)(row0 + ai * HALF + m * 16) * ldc + col0;
                float v[8];
#pragma unroll
                for (int n = 0; n < 2; ++n)
#pragma unroll
                    for (int j = 0; j < 4; ++j) { const float a = acc[ai][0][m][n][j], b = acc[ai][1][m][n][j];
                        v[n * 4 + j] = a * __builtin_amdgcn_rcpf(1.0f + __builtin_amdgcn_exp2f(-1.4426950408889634f * a)) * b; }
                u32x4 w; w.x = cvt_pk_bf16(v[0], v[1]); w.y = cvt_pk_bf16(v[2], v[3]); w.z = cvt_pk_bf16(v[4], v[5]); w.w = cvt_pk_bf16(v[6], v[7]);
                *(u32x4*)rowp = w; }
    }
};

template <class Epi, class Sched, bool ALIGN_EPI = false, bool SP2 = false>
__device__ __forceinline__ void gemm_phase(PG8_LAS unsigned char* lds, const Gemm g, const Sched& S, const Epi& E) {
#ifdef DBG_LDSNAN
    for (int i = threadIdx.x; i < 131072 / 4; i += 512) ((PG8_LAS unsigned*)lds)[i] = 0x7FC07FC0u;
    __syncthreads();
#endif
    const int tid = threadIdx.x, wid = __builtin_amdgcn_readfirstlane(tid >> 6), lane = tid & 63, wr = wid >> 2, wc = wid & 3, fr = lane & 15, fq = lane >> 4;
    const int K = g.ld ? g.ld : g.K, nt = g.K / BK;
    unsigned voffA[2], voffB[2];
#pragma unroll
    for (int i = 0; i < 2; ++i) { int R, C; stage_rc(tid * 16 + i * 8192, R, C); const int Rb = Epi::PERM ? ((R & ~31) + perm32(R & 31)) : R;
        voffA[i] = (unsigned)(R * K + C) * 2u; voffB[i] = (unsigned)(Rb * K + C) * 2u; }
    const size_t kstep = (size_t)(BK * 2);
    const size_t hstep = (size_t)HALF * K * 2;
    const size_t tstep = 2 * hstep;
    const unsigned ldsw = (unsigned)wid * 1024u;
    const int aoff = lds_byte(wr * 64 + fr, fq * 8), boff = lds_byte(wc * 32 + fr, fq * 8);
#define PG8_SA(b, h) (((b) * 2 + (h)) * HTB)
#define PG8_SB(b, h) ((4 + (b) * 2 + (h)) * HTB)
#define PG8_STAGE(bufoff, gbase, voff) do { _Pragma("unroll") for (int _i = 0; _i < 2; ++_i) \
        __builtin_amdgcn_global_load_lds((const unsigned*)((const char*)(gbase) + (voff)[_i]), (PG8_LAS unsigned*)(lds + (bufoff) + ldsw + _i * 8192), 16, 0, 0); } while (0)
#define PG8_LDA(dst, b, h) do { _Pragma("unroll") for (int m = 0; m < 4; ++m) _Pragma("unroll") for (int k = 0; k < 2; ++k) dst[m][k] = *(const PG8_LAS bf16x8*)(lds + PG8_SA(b, h) + aoff + m * 2048 + k * 1024); } while (0)
#define PG8_LDB(dst, b, h) do { _Pragma("unroll") for (int n = 0; n < 2; ++n) _Pragma("unroll") for (int k = 0; k < 2; ++k) dst[n][k] = *(const PG8_LAS bf16x8*)(lds + PG8_SB(b, h) + boff + n * 2048 + k * 1024); } while (0)
#define PG8_MMA(ai, bj, At, Bt) do { __builtin_amdgcn_s_setprio(1); _Pragma("unroll") for (int m = 0; m < 4; ++m) _Pragma("unroll") for (int n = 0; n < 2; ++n) _Pragma("unroll") for (int k = 0; k < 2; ++k) \
        acc[ai][bj][m][n] = __builtin_amdgcn_mfma_f32_16x16x32_bf16(Bt[n][k], At[m][k], acc[ai][bj][m][n], 0, 0, 0); __builtin_amdgcn_s_setprio(0); } while (0)
#define PG8_WAIT_V(n) asm volatile("s_waitcnt vmcnt(" #n ")" ::: "memory")
#define PG8_WAIT_L(n) asm volatile("s_waitcnt lgkmcnt(" #n ")" ::: "memory")
#define PG8_BAR __builtin_amdgcn_s_barrier()
#define PG8_SCHED __builtin_amdgcn_sched_barrier(0)
    Unit cur, nxt; int ui = 0;
    if (!S.next(0, cur)) return;
    f32x4 acc[2][2][4][2];
#pragma unroll
    for (int a = 0; a < 2; ++a)
#pragma unroll
        for (int b = 0; b < 2; ++b)
#pragma unroll
            for (int m = 0; m < 4; ++m)
#pragma unroll
                for (int n = 0; n < 2; ++n) acc[a][b][m][n] = (f32x4){0.f, 0.f, 0.f, 0.f};
    bf16x8 At[4][2], B0[2][2], B1[2][2];
    const char* cA = (const char*)g.A + (size_t)(Sched::APA ? cur.pa : cur.pm) * tstep; const char* cB = (const char*)g.Bt + (size_t)cur.pn * tstep;
    if constexpr (Sched::SPLITK) { cA += (size_t)cur.kofs * 2; cB += (size_t)cur.kofs * 2; }
    S.a_ready(cur);
    if constexpr (SP2) {
        PG8_STAGE(PG8_SB(0, 0), cB, voffB); PG8_STAGE(PG8_SB(0, 1), cB + hstep, voffB); PG8_STAGE(PG8_SA(0, 0), cA, voffA); PG8_STAGE(PG8_SA(0, 1), cA + hstep, voffA);
        if (wr == 1) PG8_BAR;
        PG8_WAIT_V(2); PG8_BAR;
        PG8_STAGE(PG8_SB(1, 0), cB + kstep, voffB); PG8_STAGE(PG8_SA(1, 0), cA + kstep, voffA); PG8_STAGE(PG8_SB(1, 1), cB + hstep + kstep, voffB);
        PG8_WAIT_V(6); PG8_BAR;
    } else {
        PG8_STAGE(PG8_SB(0, 0), cB, voffB); PG8_STAGE(PG8_SA(0, 0), cA, voffA); PG8_STAGE(PG8_SB(0, 1), cB + hstep, voffB); PG8_STAGE(PG8_SA(0, 1), cA + hstep, voffA);
        if (wr == 1) PG8_BAR;
        PG8_WAIT_V(4); PG8_BAR;
        PG8_STAGE(PG8_SB(1, 0), cB + kstep, voffB); PG8_STAGE(PG8_SA(1, 0), cA + kstep, voffA); PG8_STAGE(PG8_SB(1, 1), cB + hstep + kstep, voffB);
        PG8_WAIT_V(6); PG8_BAR;
    }
    for (;;) {
        const bool has_next = S.next(ui + 1, nxt);
        const char* nA = has_next ? (const char*)g.A + (size_t)(Sched::APA ? nxt.pa : nxt.pm) * tstep : cA; const char* nB = has_next ? (const char*)g.Bt + (size_t)nxt.pn * tstep : cB;
        if constexpr (Sched::SPLITK) { if (has_next) { nA += (size_t)nxt.kofs * 2; nB += (size_t)nxt.kofs * 2; } }
        const int ntu = Sched::SPLITK ? cur.nt : nt;
        for (int t = 0; t < ntu; t += 2) {
            const bool last = (t == ntu - 2);
            const char* a1 = cA + (size_t)(t + 1) * kstep;
            const char* a2 = last ? nA : cA + (size_t)(t + 2) * kstep; const char* b2 = last ? nB : cB + (size_t)(t + 2) * kstep;
            const char* a3 = a2 + kstep; const char* b3 = b2 + kstep;
            if (last && has_next) S.a_ready(nxt);
            if constexpr (SP2) {
            PG8_LDB(B0, 0, 0); PG8_LDB(B1, 0, 1); PG8_SCHED; PG8_LDA(At, 0, 0); PG8_STAGE(PG8_SA(1, 1), a1 + hstep, voffA);
            PG8_WAIT_V(8); PG8_WAIT_L(0); PG8_BAR; PG8_MMA(0, 0, At, B0); PG8_MMA(0, 1, At, B1); PG8_BAR; PG8_SCHED;
            PG8_LDA(At, 0, 1); PG8_STAGE(PG8_SB(0, 0), b2, voffB); PG8_STAGE(PG8_SB(0, 1), b2 + hstep, voffB); PG8_STAGE(PG8_SA(0, 0), a2, voffA);
            PG8_WAIT_V(8); PG8_WAIT_L(0); PG8_BAR; PG8_MMA(1, 0, At, B0); PG8_MMA(1, 1, At, B1); PG8_BAR; PG8_SCHED;
            PG8_LDB(B0, 1, 0); PG8_LDB(B1, 1, 1); PG8_SCHED; PG8_LDA(At, 1, 0); PG8_STAGE(PG8_SA(0, 1), a2 + hstep, voffA);
            PG8_WAIT_V(8); PG8_WAIT_L(0); PG8_BAR; PG8_MMA(0, 0, At, B0); PG8_MMA(0, 1, At, B1); PG8_BAR; PG8_SCHED;
            PG8_LDA(At, 1, 1); PG8_STAGE(PG8_SB(1, 0), b3, voffB); PG8_STAGE(PG8_SB(1, 1), b3 + hstep, voffB); PG8_STAGE(PG8_SA(1, 0), a3, voffA);
            PG8_WAIT_V(8); PG8_WAIT_L(0); PG8_BAR; PG8_MMA(1, 0, At, B0); PG8_MMA(1, 1, At, B1); PG8_BAR; PG8_SCHED;
            } else {
            PG8_LDB(B0, 0, 0); PG8_SCHED; PG8_LDA(At, 0, 0); PG8_STAGE(PG8_SA(1, 1), a1 + hstep, voffA);
            PG8_WAIT_L(8); PG8_BAR; PG8_WAIT_L(0); PG8_MMA(0, 0, At, B0); PG8_BAR; PG8_SCHED;
            PG8_LDB(B1, 0, 1); PG8_STAGE(PG8_SB(0, 0), b2, voffB);
            PG8_BAR; PG8_WAIT_L(0); PG8_MMA(0, 1, At, B1); PG8_BAR;
            PG8_LDA(At, 0, 1); PG8_STAGE(PG8_SA(0, 0), a2, voffA);
            PG8_BAR; PG8_WAIT_L(0); PG8_MMA(1, 0, At, B0); PG8_BAR; PG8_SCHED;
            PG8_STAGE(PG8_SB(0, 1), b2 + hstep, voffB);
            PG8_WAIT_V(6); PG8_BAR; PG8_MMA(1, 1, At, B1); PG8_BAR;
            PG8_LDB(B0, 1, 0); PG8_SCHED; PG8_LDA(At, 1, 0); PG8_STAGE(PG8_SA(0, 1), a2 + hstep, voffA);
            PG8_WAIT_L(8); PG8_BAR; PG8_WAIT_L(0); PG8_MMA(0, 0, At, B0); PG8_BAR; PG8_SCHED;
            PG8_LDB(B1, 1, 1); PG8_STAGE(PG8_SB(1, 0), b3, voffB);
            PG8_BAR; PG8_WAIT_L(0); PG8_MMA(0, 1, At, B1); PG8_BAR;
            PG8_LDA(At, 1, 1); PG8_STAGE(PG8_SA(1, 0), a3, voffA);
            PG8_BAR; PG8_WAIT_L(0); PG8_MMA(1, 0, At, B0); PG8_BAR; PG8_SCHED;
            PG8_STAGE(PG8_SB(1, 1), b3 + hstep, voffB);
            PG8_WAIT_V(6); PG8_BAR; PG8_MMA(1, 1, At, B1); PG8_BAR;
            }
        }
        if constexpr (ALIGN_EPI) { if (wr == 0) PG8_BAR; }
        if constexpr (!Epi::AFTER_DRAIN) { E(acc, cur, wr, wc, fr, fq); S.done(cur); }
        if (!has_next) break;
#pragma unroll
        for (int a = 0; a < 2; ++a)
#pragma unroll
            for (int b = 0; b < 2; ++b)
#pragma unroll
                for (int m = 0; m < 4; ++m)
#pragma unroll
                    for (int n = 0; n < 2; ++n) acc[a][b][m][n] = (f32x4){0.f, 0.f, 0.f, 0.f};
        cur = nxt; cA = nA; cB = nB; ++ui;
        if constexpr (ALIGN_EPI) { if (wr == 1) PG8_BAR; }
    }
    PG8_WAIT_V(0);
    if constexpr (!ALIGN_EPI) { if (wr == 0) PG8_BAR; }
    PG8_BAR;
#undef PG8_SA
#undef PG8_SB
#undef PG8_STAGE
#undef PG8_LDA
#undef PG8_LDB
#undef PG8_MMA
#undef PG8_WAIT_V
#undef PG8_WAIT_L
#undef PG8_BAR
#undef PG8_SCHED
}
}

constexpr int LDS_BYTES = 147456;
constexpr int MISC_OFF = 131072 + 320;
constexpr int NWAVES = 8, NT = 512;
constexpr int D = 2048, SEQ = 4096, M = 8192;
constexpr int RW = 768, RH = 12;
constexpr int FH = 6;
constexpr int NHZ = 6144;
constexpr int HC_WD = 2304, HC_Q = 2560, HC_FK = 3328, HC_FV = 4096, HC_U = 4864, HC_SV = 5376, HC_FF = 5888;
constexpr int DFF = 5632, DFE = 2816, NE = 8;
constexpr int NMOD = 6 * D;
constexpr int MOE_ROWS = 18432;
constexpr float LOG2E = 1.4426950408889634f;

constexpr size_t MiB = 1u << 20;
constexpr size_t WS_CTL = 0, CTL_ZERO_BYTES = 1 * MiB;
constexpr size_t WS_MOD = 1 * MiB;
constexpr size_t WS_TOK = 2 * MiB;
constexpr size_t WS_BIAS = 3 * MiB;
constexpr size_t WS_WLT = 3 * MiB + 256 * 1024;
constexpr size_t WS_WIN = 4 * MiB;
constexpr size_t WS_WOUT = 52 * MiB;
constexpr size_t WS_W13 = 68 * MiB;
constexpr size_t WS_W2T = 112 * MiB;
constexpr size_t WS_MW13 = 134 * MiB;
constexpr size_t WS_MW2T = 310 * MiB;
constexpr size_t WS_HB = 398 * MiB;
constexpr size_t WS_OB = 430 * MiB;
constexpr size_t WS_X1 = 462 * MiB;
constexpr size_t WS_U = 526 * MiB;
constexpr size_t WS_HZ = WS_U;
constexpr size_t WS_RW = WS_U + 192 * MiB;
constexpr size_t RWSZ = 24 * MiB;
constexpr size_t WS_CHP = WS_RW;
constexpr size_t WS_CHR2 = WS_RW + 12 * MiB;
constexpr size_t WS_CHQ = WS_RW + 24 * MiB;
constexpr size_t WS_CHY0 = WS_RW + 48 * MiB;
constexpr size_t WS_CHHS = WS_RW + 72 * MiB;
constexpr size_t WS_Y = WS_RW + 84 * MiB;
constexpr size_t WS_VB = WS_RW + 108 * MiB;
constexpr size_t WS_GB = WS_RW + 120 * MiB;
constexpr size_t WS_BS = WS_RW + 132 * MiB;
constexpr size_t WS_YORA = WS_RW + 140 * MiB;
constexpr size_t WS_QF = WS_RW + 7 * RWSZ;
constexpr size_t WS_KF = WS_QF + 12 * MiB;
constexpr size_t WS_VT = WS_KF + 12 * MiB;
constexpr size_t WS_ACT = WS_U;
constexpr size_t WS_HS = WS_U + 100 * MiB;
constexpr size_t WS_YB = WS_U + 172 * MiB;
constexpr size_t WS_YB2 = WS_U + 244 * MiB;
constexpr size_t WS_END = WS_VT + 12 * MiB;
static_assert(WS_YB + (size_t)MOE_ROWS * 2048 * 4 <= WS_END, "ws map");
constexpr int CW_BAR = 4096;
constexpr int CW_ATQ = 20480;
constexpr int CW_CNT = 16384;
constexpr size_t TK_EXP = 0, TK_RANK = 65536 * 1, TK_GATE = 65536 * 2, TK_POS = 65536 * 3, TK_STOK = 65536 * 4;

#define GAS __attribute__((address_space(1)))
#define LAS __attribute__((address_space(3)))
typedef unsigned short bf16;
typedef unsigned v4u __attribute__((ext_vector_type(4)));
typedef unsigned v2u __attribute__((ext_vector_type(2)));
typedef float f32x4 __attribute__((ext_vector_type(4)));
typedef float f32x2 __attribute__((ext_vector_type(2)));
typedef short bf16x8 __attribute__((ext_vector_type(8)));
#define LDS_WAIT() asm volatile("s_waitcnt lgkmcnt(0)" ::: "memory")
#define VM_WAIT() asm volatile("s_waitcnt vmcnt(0)" ::: "memory")
__device__ __forceinline__ unsigned pk2(float lo, float hi) { return pg8::cvt_pk_bf16(lo, hi); }
__device__ __forceinline__ unsigned f2bf(float f) { return pg8::cvt_pk_bf16(f, f) & 0xffffu; }
#define DPP_F(v, ctrl) __builtin_bit_cast(float, __builtin_amdgcn_update_dpp(0, __builtin_bit_cast(int, (v)), (ctrl), 0xF, 0xF, false))
#define RDL_F(v, l) __builtin_bit_cast(float, __builtin_amdgcn_readlane(__builtin_bit_cast(int, (v)), (l)))
__device__ __forceinline__ float wave_sum(float v) {
    v += DPP_F(v, 0xB1); v += DPP_F(v, 0x4E); v += DPP_F(v, 0x141); v += DPP_F(v, 0x140);
    return (RDL_F(v, 15) + RDL_F(v, 31)) + (RDL_F(v, 47) + RDL_F(v, 63));
}
__device__ __forceinline__ float bf2f(unsigned short h) { return __uint_as_float(((unsigned)h) << 16); }
__device__ __forceinline__ void unpack8(const v4u w, float (&f)[8]) { f[0] = __uint_as_float(w.x << 16); f[1] = __uint_as_float(w.x & 0xffff0000u); f[2] = __uint_as_float(w.y << 16); f[3] = __uint_as_float(w.y & 0xffff0000u);
    f[4] = __uint_as_float(w.z << 16); f[5] = __uint_as_float(w.z & 0xffff0000u); f[6] = __uint_as_float(w.w << 16); f[7] = __uint_as_float(w.w & 0xffff0000u); }
__device__ __forceinline__ float wave_max(float v) {
    v = fmaxf(v, DPP_F(v, 0xB1)); v = fmaxf(v, DPP_F(v, 0x4E)); v = fmaxf(v, DPP_F(v, 0x141)); v = fmaxf(v, DPP_F(v, 0x140));
    return fmaxf(fmaxf(RDL_F(v, 15), RDL_F(v, 31)), fmaxf(RDL_F(v, 47), RDL_F(v, 63)));
}
__device__ __forceinline__ float wave_min(float v) { return -wave_max(-v); }
__device__ __forceinline__ float row16_sum(float v) { v += DPP_F(v, 0xB1); v += DPP_F(v, 0x4E); v += DPP_F(v, 0x141); v += DPP_F(v, 0x140); return v; }
__device__ __forceinline__ float quad_sum(float v) { v += DPP_F(v, 0xB1); v += DPP_F(v, 0x4E); return v; }
__device__ __forceinline__ float fast_sigmoid(float x) { return __builtin_amdgcn_rcpf(1.0f + __expf(-x)); }
__device__ __forceinline__ float fast_tanh(float x) { const float e = __expf(-2.0f * fabsf(x)); const float t = (1.0f - e) * __builtin_amdgcn_rcpf(1.0f + e); return x < 0.f ? -t : t; }
__device__ __forceinline__ float gelu_tanh(float x) { const float u2 = -2.302208198f * (x + 0.044715f * x * x * x); return x * __builtin_amdgcn_rcpf(1.0f + __builtin_amdgcn_exp2f(u2)); }
__device__ __forceinline__ float softplusf(float x) { return fmaxf(x, 0.f) + log1pf(__expf(-fabsf(x))); }
__device__ __forceinline__ float fast_softplus(float x) { return fmaxf(x, 0.f) + __logf(1.0f + __expf(-fabsf(x))); }

#define XB_TMO      128
#define XB_XCNT(j)  (256  + 64 * (j))
#define XB_XSUB(j)  (1280 + 64 * (j))
#define XB_XGEN(j)  (2304 + 64 * (j))
#define XB_TOP      3328
#define XB_TOPGEN   3392
#define XCD_BAR_WORDS 3456
#define XB_SPIN_CAP (1u << 18)
__device__ __forceinline__ unsigned xb_ld(unsigned* p)              { return __hip_atomic_load(p, __ATOMIC_RELAXED, __HIP_MEMORY_SCOPE_AGENT); }
__device__ __forceinline__ unsigned xb_add(unsigned* p, unsigned v) { return __hip_atomic_fetch_add(p, v, __ATOMIC_RELAXED, __HIP_MEMORY_SCOPE_AGENT); }
__device__ __forceinline__ unsigned xb_xcc_id() { return (unsigned)__builtin_amdgcn_s_getreg((3 << 11) | 20) & 0xFu; }
#define XB_SPIN(cond, bar) do { unsigned _sp = 0; while (cond) { __builtin_amdgcn_s_sleep(1); \
    if ((++_sp & 255u) == 0u) { if (xb_ld(&(bar)[XB_TMO])) break; if (_sp > XB_SPIN_CAP) { atomicAdd(&(bar)[XB_TMO], 1u); break; } } } } while (0)
struct XcdBarrier { unsigned* bar; unsigned x; volatile LAS unsigned* st; };
__device__ __forceinline__ XcdBarrier xcd_barrier_post(unsigned* bar, volatile LAS unsigned* st) {
    XcdBarrier b; b.bar = bar; b.x = xb_xcc_id(); b.st = st;
    if (threadIdx.x == 0) (void)xb_add(&bar[XB_XCNT(b.x)], 1u);
    return b;
}
__device__ __forceinline__ void xcd_barrier_complete(unsigned* bar, unsigned x, unsigned& nloc, unsigned& nx) {
    const unsigned G = gridDim.x * gridDim.y * gridDim.z;
    unsigned sum, cnt, mine, sp = 0u;
    for (;;) {
        sum = 0u; cnt = 0u; mine = 0u;
#pragma unroll
        for (unsigned j = 0; j < 16; ++j) { const unsigned c = xb_ld(&bar[XB_XCNT(j)]); sum += c; cnt += (c > 0u) ? 1u : 0u; mine = (j == x) ? c : mine; }
        if (sum == G) break;
        __builtin_amdgcn_s_sleep(1);
        if ((++sp & 255u) == 0u) { if (xb_ld(&bar[XB_TMO])) break; if (sp > XB_SPIN_CAP) { atomicAdd(&bar[XB_TMO], 1u); break; } }
    }
    nloc = mine > 0u ? mine : 1u; nx = cnt > 0u ? cnt : 1u;
}
__device__ __forceinline__ void xcd_barrier(const XcdBarrier& b) {
    asm volatile("s_waitcnt vmcnt(0)" ::: "memory");
    __syncthreads();
    if (threadIdx.x == 0) {
        unsigned* bar = b.bar;
        __builtin_amdgcn_s_waitcnt(0);
        unsigned nloc = b.st[0], nx = b.st[1];
        if (nloc == 0u) { xcd_barrier_complete(bar, b.x, nloc, nx); b.st[0] = nloc; b.st[1] = nx; }
        const unsigned old = xb_add(&bar[XB_XSUB(b.x)], 1u);
        const unsigned gen = old / nloc;
        if (old + 1u == (gen + 1u) * nloc) {
            __builtin_amdgcn_fence(__ATOMIC_RELEASE, "agent");
            asm volatile("s_waitcnt vmcnt(0)" ::: "memory");
            const unsigned og = xb_add(&bar[XB_TOP], 1u);
            const unsigned tg = og / nx;
            if (og + 1u == (tg + 1u) * nx) xb_add(&bar[XB_TOPGEN], 1u);
            else XB_SPIN(xb_ld(&bar[XB_TOPGEN]) == tg, bar);
            __builtin_amdgcn_fence(__ATOMIC_ACQUIRE, "agent");
            xb_add(&bar[XB_XGEN(b.x)], 1u);
            asm volatile("s_waitcnt vmcnt(0)" ::: "memory");
        } else {
            XB_SPIN(xb_ld(&bar[XB_XGEN(b.x)]) == gen, bar);
            __builtin_amdgcn_fence(__ATOMIC_ACQUIRE, "agent");
            asm volatile("s_waitcnt vmcnt(0)" ::: "memory");
        }
    }
    __syncthreads();
}

struct Args { const float* in[34]; float* out; unsigned char* ws; int ph_lo, ph_hi; };
enum { I_X = 0, I_C, I_ADAW, I_ADAB, I_N1G, I_N2G, I_WIN, I_MU, I_W0, I_W2, I_A0, I_A2, I_G2, I_KK, I_KA, I_RK, I_LNXG, I_LNXB, I_QNG, I_KNG, I_FB,
       I_SGLNG, I_SGLNB, I_SGWS, I_SGB, I_WOUT, I_FW1, I_FW3, I_FW2, I_MRW, I_MRB, I_MW1, I_MW3, I_MW2 };

struct CvtP { const float* src; bf16* dst; int ldw; int K; int nvalid; int pad; };
__device__ __forceinline__ void cvt_fill(CvtP& P, const float* W, int ldw, int K, int k0, int src_c0, int nvalid, bf16* WT, size_t dst_row0, int dst_koff) {
    P.src = W + (size_t)k0 * ldw + src_c0; P.dst = WT + dst_row0 * K + k0 + dst_koff; P.ldw = ldw; P.K = K; P.nvalid = nvalid; P.pad = 0; }
__device__ __forceinline__ void cvt_load(const CvtP& P, float (&v)[32], int lane) {
    const int j = lane & 31; const float* p = P.src + (size_t)(lane >> 5) * P.ldw + j; const bool ok = j < P.nvalid;
#pragma unroll
    for (int i = 0; i < 32; ++i) { v[i] = 0.f; if (ok) v[i] = *(const GAS float*)(p + (size_t)(2 * i) * P.ldw); }
}
__device__ __forceinline__ void cvt_finish(const CvtP& P, const float (&v)[32], LAS float* scr, int lane) {
#pragma unroll
    for (int i = 0; i < 32; ++i) scr[(2 * i + (lane >> 5)) * 33 + (lane & 31)] = v[i];
    LDS_WAIT(); asm volatile("" ::: "memory");
    const int c = lane & 7;
#pragma unroll
    for (int jj = 0; jj < 4; ++jj) { const int n = (lane >> 3) + 8 * jj; const LAS float* s = scr + (8 * c) * 33 + n;
        v4u o; o.x = pk2(s[0 * 33], s[1 * 33]); o.y = pk2(s[2 * 33], s[3 * 33]); o.z = pk2(s[4 * 33], s[5 * 33]); o.w = pk2(s[6 * 33], s[7 * 33]);
        *(GAS v4u*)(P.dst + (size_t)n * P.K + 8 * c) = o; }
    LDS_WAIT(); asm volatile("" ::: "memory");
}
constexpr int IT_WIN = 192 * 32, IT_WOUT = 64 * 32, IT_W13 = 352 * 32, IT_W2 = 64 * 88, IT_MW13 = 176 * 32, IT_MW2 = 64 * 44;
constexpr int IT_LORA = 192;
constexpr int IT_TOTAL = 2 * IT_WIN + 2 * IT_WOUT + IT_W13 + IT_W2 + 8 * IT_MW13 + 8 * IT_MW2 + IT_LORA;


__device__ __forceinline__ void cvt_decode(const Args& a, int it, CvtP& P) {
    unsigned char* ws = a.ws;
        int r = it;
        if (r < 2 * IT_WIN) { const int l = r / IT_WIN; r -= l * IT_WIN; const int kb = r / 192, g = r % 192, d0 = 32 * g;
            int sc0, nv; if (d0 < HC_U) { sc0 = d0; nv = 32; } else if (d0 < HC_FF) { sc0 = d0 + 6; nv = 32; } else if (d0 == HC_FF) { sc0 = 4864; nv = 6; } else { sc0 = 0; nv = 0; }
            cvt_fill(P, a.in[I_WIN] + (size_t)l * D * 5894, 5894, D, 64 * kb, sc0, nv, (bf16*)(ws + WS_WIN) + (size_t)l * NHZ * D, d0, 0); return; }
        r -= 2 * IT_WIN;
        if (r < 2 * IT_WOUT) { const int l = r / IT_WOUT; r -= l * IT_WOUT; const int kb = r / 64, g = r % 64;
            cvt_fill(P, a.in[I_WOUT] + (size_t)l * D * D, D, D, 64 * kb, 32 * g, 32, (bf16*)(ws + WS_WOUT) + (size_t)l * D * D, 32 * g, 0); return; }
        r -= 2 * IT_WOUT;
        if (r < IT_W13) { const int kb = r / 352, g = r % 352, p = g >> 3, s = (g >> 2) & 1, i0 = (g & 3) * 32;
            cvt_fill(P, s ? a.in[I_FW3] : a.in[I_FW1], DFF, D, 64 * kb, 128 * p + i0, 32, (bf16*)(ws + WS_W13), 32 * g, 0); return; }
        r -= IT_W13;
        if (r < IT_W2) { const int kb = r / 64, g = r % 64;
            cvt_fill(P, a.in[I_FW2], D, DFF, 64 * kb, 32 * g, 32, (bf16*)(ws + WS_W2T), 32 * g, 0); return; }
        r -= IT_W2;
        if (r < 8 * IT_MW13) { const int e = r / IT_MW13; r -= e * IT_MW13; const int kb = r / 176, g = r % 176, p = g >> 3, s = (g >> 2) & 1, i0 = (g & 3) * 32;
            cvt_fill(P, (s ? a.in[I_MW3] : a.in[I_MW1]) + (size_t)e * D * DFE, DFE, D, 64 * kb, 128 * p + i0, 32, (bf16*)(ws + WS_MW13) + (size_t)e * DFF * D, 32 * g, 0); return; }
        r -= 8 * IT_MW13;
        if (r >= 8 * IT_MW2) { r -= 8 * IT_MW2; const int l = r / 96; r -= l * 96; bf16* dst = (bf16*)(ws + WS_WLT) + (size_t)l * RW * 256;
            if (r < 24) cvt_fill(P, a.in[I_W2] + (size_t)l * 64 * RW, RW, 256, 0, 32 * r, 32, dst, 32 * r, 0);
            else if (r < 48) cvt_fill(P, a.in[I_A2] + (size_t)l * 64 * RW, RW, 256, 0, 32 * (r - 24), 32, dst, 32 * (r - 24), 64);
            else { const int q = r - 48, kb = q / 24, g = q % 24; cvt_fill(P, a.in[I_G2] + (size_t)l * 128 * RW, RW, 256, 64 * kb, 32 * g, 32, dst, 32 * g, 128); }
            return; }
        { const int e = r / IT_MW2; r -= e * IT_MW2; const int kb = r / 64, g = r % 64;
            cvt_fill(P, a.in[I_MW2] + (size_t)e * DFE * D, D, DFE, 64 * kb, 32 * g, 32, (bf16*)(ws + WS_MW2T) + (size_t)e * D * DFE, 32 * g, 0); }
}
__device__ __forceinline__ void p0_convert(const Args& a, LAS unsigned char* lds, int gw, int ngw, int wave, int lane) {
    LAS float* scr = (LAS float*)(lds + 32768 + wave * 8704);
#pragma unroll 1
    for (int it = gw; it < IT_TOTAL; it += 2 * ngw) {
        CvtP P0, P1; float v0[32], v1[32];
        cvt_decode(a, it, P0); cvt_load(P0, v0, lane);
        const bool two = it + ngw < IT_TOTAL;
        if (two) { cvt_decode(a, it + ngw, P1); cvt_load(P1, v1, lane); }
        cvt_finish(P0, v0, scr, lane);
        if (two) cvt_finish(P1, v1, scr, lane);
    }
}
__device__ __forceinline__ void p0_mod(const Args& a, LAS unsigned char* lds, int tid, int wave, int lane) {
    LAS float* cs = (LAS float*)lds;
    LAS float* red = (LAS float*)(lds + 16384);
    bool have = false;
    for (int u = blockIdx.x; u < 384; u += gridDim.x) {
        if (!have) { for (int i = tid; i < 4096; i += NT) { const float v = a.in[I_C][i]; cs[i] = v / (1.0f + __expf(-v)); } have = true; }
        __syncthreads();
        const int l = u / 192, jb = u % 192;
        const float* W = a.in[I_ADAW] + (size_t)l * D * NMOD + 64 * jb + lane;
        float a0 = 0.f, a1 = 0.f;
#pragma unroll 8
        for (int kk = 0; kk < 256; ++kk) { const int k = 256 * wave + kk; const float wv = W[(size_t)k * NMOD]; a0 += cs[k] * wv; a1 += cs[2048 + k] * wv; }
        red[(wave * 2 + 0) * 64 + lane] = a0; red[(wave * 2 + 1) * 64 + lane] = a1;
        __syncthreads();
        if (tid < 128) { const int b = tid >> 6, j = tid & 63; float s = 0.f;
#pragma unroll
            for (int w = 0; w < 8; ++w) s += red[(w * 2 + b) * 64 + j];
            ((float*)(a.ws + WS_MOD))[(size_t)(l * 2 + b) * NMOD + 64 * jb + j] = s + a.in[I_ADAB][(size_t)l * NMOD + 64 * jb + j]; }
    }
    __syncthreads();
}

template <bool MOE, bool INBF>
__device__ __forceinline__ void adaln_rows(const Args& a, const void* xin_, const float* g, const float* modl, int sh_off, int sc_off, bf16* out, int gw, int ngw, int lane, LAS unsigned char* lds = nullptr, int tid = 0) {
    f32x4 v[8];
    LAS f32x4* RWL = (LAS f32x4*)lds;
    if (MOE) {
        for (int idx = tid; idx < 4096; idx += NT) { const int ln = idx & 63, h = (idx >> 6) & 1, q = (idx >> 7) & 3, j = idx >> 9;
            RWL[idx] = *(const f32x4*)(a.in[I_MRW] + (size_t)(4 * (ln + 64 * j) + q) * NE + 4 * h); }
        __syncthreads();
    }
#define ADA_LOAD(dst, mrow) do { if (INBF) { const GAS v2u* xr_ = (const GAS v2u*)((const bf16*)xin_ + (size_t)(mrow) * D) + lane; \
            _Pragma("unroll") for (int j = 0; j < 8; ++j) { const v2u w_ = xr_[64 * j]; dst[j] = (f32x4){__uint_as_float(w_.x << 16), __uint_as_float(w_.x & 0xffff0000u), __uint_as_float(w_.y << 16), __uint_as_float(w_.y & 0xffff0000u)}; } } \
        else { const GAS f32x4* xr_ = (const GAS f32x4*)((const float*)xin_ + (size_t)(mrow) * D) + lane; _Pragma("unroll") for (int j = 0; j < 8; ++j) dst[j] = xr_[64 * j]; } } while (0)
    const int nrow = (M + ngw - 1) / ngw, m0 = gw * nrow, m1 = (m0 + nrow < M) ? m0 + nrow : M;
    f32x4 PA[8], PB[8]; int bcur = -1;
    auto params = [&](int b) { if (b != bcur) { bcur = b;
            const f32x4* gr = (const f32x4*)g + lane;
            const f32x4* scr = (const f32x4*)(modl + (size_t)b * NMOD + sc_off) + lane;
            const f32x4* shr = (const f32x4*)(modl + (size_t)b * NMOD + sh_off) + lane;
#pragma unroll
            for (int j = 0; j < 8; ++j) { PA[j] = gr[64 * j] * (scr[64 * j] + 1.0f); PB[j] = shr[64 * j]; } } };
    auto process = [&](const f32x4 (&v)[8], int m) {
        float ss = 0.f;
#pragma unroll
        for (int j = 0; j < 8; ++j) { ss += (v[j].x * v[j].x + v[j].y * v[j].y) + (v[j].z * v[j].z + v[j].w * v[j].w); }
        const float rstd = __builtin_amdgcn_rsqf(wave_sum(ss) * (1.0f / D) + 1e-6f);
        GAS v2u* o8 = (GAS v2u*)(out + (size_t)m * D) + lane;
        float lg[8]; v2u orow[8];
        LAS f32x4* rwl = RWL + lane; if (MOE) asm volatile("" : "+v"(rwl));
        if (MOE) {
#pragma unroll
            for (int e = 0; e < 8; ++e) lg[e] = 0.f; }
#pragma unroll
        for (int j = 0; j < 8; ++j) {
            f32x4 y = v[j] * rstd * PA[j] + PB[j];
            v2u o; o.x = pk2(y.x, y.y); o.y = pk2(y.z, y.w); if (MOE) orow[j] = o; else o8[64 * j] = o;
            if (MOE) {
#pragma unroll
                for (int q = 0; q < 4; ++q) { const f32x4 r0 = rwl[((j * 4 + q) * 2 + 0) * 64], r1 = rwl[((j * 4 + q) * 2 + 1) * 64]; const float yy = y[q];
                    lg[0] += yy * r0.x; lg[1] += yy * r0.y; lg[2] += yy * r0.z; lg[3] += yy * r0.w; lg[4] += yy * r1.x; lg[5] += yy * r1.y; lg[6] += yy * r1.z; lg[7] += yy * r1.w; } }
        }
        if (MOE) {
#pragma unroll
            for (int e = 0; e < 8; ++e) lg[e] = wave_sum(lg[e]) + a.in[I_MRB][e];
            int i0 = 0; float v0 = lg[0];
#pragma unroll
            for (int e = 1; e < 8; ++e) if (lg[e] > v0) { v0 = lg[e]; i0 = e; }
            int i1 = -1; float v1 = -3.0e38f;
#pragma unroll
            for (int e = 0; e < 8; ++e) if (e != i0 && lg[e] > v1) { v1 = lg[e]; i1 = e; }
            i0 = __builtin_amdgcn_readfirstlane(i0); i1 = __builtin_amdgcn_readfirstlane(i1);
            unsigned r0 = 0, r1 = 0;
            if (lane == 0) {
                const float w0 = 1.0f / (1.0f + __expf(v1 - v0)), w1 = 1.0f - w0;
                unsigned* cnt = (unsigned*)(a.ws + WS_CTL) + CW_CNT;
                r0 = xb_add(cnt + 64 * i0, 1u); r1 = xb_add(cnt + 64 * i1, 1u);
                unsigned char* tk = a.ws + WS_TOK;
                ((int*)(tk + TK_EXP))[m] = i0; ((int*)(tk + TK_EXP))[8192 + m] = i1;
                ((int*)(tk + TK_RANK))[m] = (int)r0; ((int*)(tk + TK_RANK))[8192 + m] = (int)r1;
                ((float*)(tk + TK_GATE))[m] = w0; ((float*)(tk + TK_GATE))[8192 + m] = w1;
            }
            r0 = (unsigned)__builtin_amdgcn_readfirstlane((int)r0); r1 = (unsigned)__builtin_amdgcn_readfirstlane((int)r1);
            GAS v2u* d0 = (GAS v2u*)(out + ((size_t)i0 * 8192 + r0) * D) + lane; GAS v2u* d1 = (GAS v2u*)(out + ((size_t)i1 * 8192 + r1) * D) + lane;
#pragma unroll
            for (int j = 0; j < 8; ++j) { d0[64 * j] = orow[j]; d1[64 * j] = orow[j]; }
        }
    };
    if constexpr (INBF) {
        for (int mg = m0; mg < m1; mg += 4) {
            params(mg >> 12);
            v2u raw[4][8];
#pragma unroll
            for (int r = 0; r < 4; ++r) if (mg + r < m1) { const GAS v2u* xr_ = (const GAS v2u*)((const bf16*)xin_ + (size_t)(mg + r) * D) + lane;
#pragma unroll
                for (int j = 0; j < 8; ++j) raw[r][j] = xr_[64 * j]; }
#pragma unroll
            for (int r = 0; r < 4; ++r) if (mg + r < m1) { params((mg + r) >> 12);
                f32x4 vv[8];
#pragma unroll
                for (int j = 0; j < 8; ++j) { const v2u w_ = raw[r][j]; vv[j] = (f32x4){__uint_as_float(w_.x << 16), __uint_as_float(w_.x & 0xffff0000u), __uint_as_float(w_.y << 16), __uint_as_float(w_.y & 0xffff0000u)}; }
                process(vv, mg + r); }
        }
    } else {
        for (int mg = m0; mg < m1; mg += 4) {
            params(mg >> 12);
            f32x4 rawf[4][8];
#pragma unroll
            for (int r = 0; r < 4; ++r) if (mg + r < m1) { const GAS f32x4* xr_ = (const GAS f32x4*)((const float*)xin_ + (size_t)(mg + r) * D) + lane;
#pragma unroll
                for (int j = 0; j < 8; ++j) rawf[r][j] = xr_[64 * j]; }
#pragma unroll
            for (int r = 0; r < 4; ++r) if (mg + r < m1) { params((mg + r) >> 12); process(rawf[r], mg + r); }
        }
    }
}

#define SW128(row, chunk) ((row) * 256 + ((((chunk) ^ ((row) & 15))) << 4))
__device__ __forceinline__ void sgu_unit(const Args& a, int l, int u, LAS unsigned char* lds, int tid, int wave, int lane) {
    const int g = u & 3, n = (u >> 2) & 31, b = u >> 7, fr = lane & 15, fq = lane >> 4;
    const bf16* HZ = (const bf16*)(a.ws + WS_HZ);
    LAS unsigned char* WSI = lds;
    LAS unsigned char* VTI = lds + 32768;
    const size_t m0 = (size_t)b * SEQ + n * 128;
    {   const int q = tid >> 2, c0 = (tid & 3) * 32;
        const bf16* src = HZ + (m0 + q) * NHZ + HC_SV + 128 * g + c0;
        float v[32]; float s = 0.f;
#pragma unroll
        for (int i = 0; i < 4; ++i) { float f8[8]; unpack8(*(const GAS v4u*)(src + 8 * i), f8);
#pragma unroll
            for (int e = 0; e < 8; ++e) v[8 * i + e] = gelu_tanh(f8[e]); }
#pragma unroll
        for (int i = 0; i < 32; ++i) s += v[i];
        s = quad_sum(s);
        const float mu = s * (1.0f / 128.0f); float q2 = 0.f;
#pragma unroll
        for (int i = 0; i < 32; ++i) { v[i] -= mu; q2 += v[i] * v[i]; }
        q2 = quad_sum(q2);
        const float rstd = __builtin_amdgcn_rsqf(q2 * (1.0f / 128.0f) + 1e-5f);
        const float* lg = a.in[I_SGLNG] + (size_t)(l * 4 + g) * 128 + c0; const float* lb = a.in[I_SGLNB] + (size_t)(l * 4 + g) * 128 + c0;
#pragma unroll
        for (int i = 0; i < 32; ++i) { const int c = c0 + i; *(LAS bf16*)(VTI + SW128(c, q >> 3) + (q & 7) * 2) = (bf16)f2bf(v[i] * rstd * lg[i] + lb[i]); }
        const int p = tid >> 2, q0 = (tid & 3) * 32; const float* wsrc = a.in[I_SGWS] + (size_t)(l * 4 + g) * 16384 + p * 128 + q0;
#pragma unroll
        for (int j = 0; j < 4; ++j) { const f32x4 w0 = *(const f32x4*)(wsrc + 8 * j), w1 = *(const f32x4*)(wsrc + 8 * j + 4); const int qq = q0 + 8 * j;
            v4u o; o.x = pk2(qq + 0 <= p ? w0.x : 0.f, qq + 1 <= p ? w0.y : 0.f); o.y = pk2(qq + 2 <= p ? w0.z : 0.f, qq + 3 <= p ? w0.w : 0.f);
            o.z = pk2(qq + 4 <= p ? w1.x : 0.f, qq + 5 <= p ? w1.y : 0.f); o.w = pk2(qq + 6 <= p ? w1.z : 0.f, qq + 7 <= p ? w1.w : 0.f);
            *(LAS v4u*)(WSI + SW128(p, qq >> 3)) = o; }
    }
    __syncthreads();
    {   const int pb = wave;
        const int nks = (16 * pb + 15) / 32 + 1;
        bf16x8 af[4];
#pragma unroll
        for (int ks = 0; ks < 4; ++ks) af[ks] = *(const LAS bf16x8*)(WSI + SW128(16 * pb + fr, 4 * ks + fq));
        bf16* OB = (bf16*)(a.ws + WS_OB);
        const float sbp = a.in[I_SGB][(size_t)(l * 4 + g) * 128 + 16 * pb + fr];
        const size_t prow = m0 + 16 * pb + fr;
        v2u uraw[8];
#pragma unroll
        for (int cb = 0; cb < 8; ++cb) uraw[cb] = *(const GAS v2u*)(HZ + prow * NHZ + HC_U + 128 * g + 16 * cb + 4 * fq);
#pragma unroll
        for (int cb = 0; cb < 8; ++cb) { f32x4 acc = (f32x4){0.f, 0.f, 0.f, 0.f};
#pragma unroll
            for (int ks = 0; ks < 4; ++ks) if (ks < nks) acc = __builtin_amdgcn_mfma_f32_16x16x32_bf16(*(const LAS bf16x8*)(VTI + SW128(16 * cb + fr, 4 * ks + fq)), af[ks], acc, 0, 0, 0);
            const float u0 = __uint_as_float(uraw[cb].x << 16), u1 = __uint_as_float(uraw[cb].x & 0xffff0000u), u2 = __uint_as_float(uraw[cb].y << 16), u3 = __uint_as_float(uraw[cb].y & 0xffff0000u);
            v2u o; o.x = pk2(gelu_tanh(u0) * (acc[0] + sbp), gelu_tanh(u1) * (acc[1] + sbp)); o.y = pk2(gelu_tanh(u2) * (acc[2] + sbp), gelu_tanh(u3) * (acc[3] + sbp));
            *(GAS v2u*)(OB + prow * D + 1536 + 128 * g + 16 * cb + 4 * fq) = o; }
    }
    __syncthreads();
}
__device__ __forceinline__ void fox_prep_unit(const Args& a, int l, int u, LAS unsigned char* lds, int tid, int wave, int lane) {
    const bf16* HZ = (const bf16*)(a.ws + WS_HZ);
    const int b = u >> 7, t0 = (u & 127) * 32;
    const size_t m0 = (size_t)b * SEQ + t0;
    bf16* QF = (bf16*)(a.ws + WS_QF); bf16* KF = (bf16*)(a.ws + WS_KF); bf16* VT = (bf16*)(a.ws + WS_VT);
    {   const int t = tid >> 4, d0 = (tid & 15) * 48; const bf16* src = HZ + (m0 + t) * NHZ + HC_FV + d0;
        v4u vv[6];
#pragma unroll
        for (int i = 0; i < 6; ++i) vv[i] = *(const GAS v4u*)(src + 8 * i);
#pragma unroll
        for (int i = 0; i < 6; ++i) { LAS unsigned char* p = lds + (d0 + 8 * i) * 68 + t * 2;
            *(LAS bf16*)(p) = (bf16)(vv[i].x & 0xffffu); *(LAS bf16*)(p + 68) = (bf16)(vv[i].x >> 16); *(LAS bf16*)(p + 136) = (bf16)(vv[i].y & 0xffffu); *(LAS bf16*)(p + 204) = (bf16)(vv[i].y >> 16);
            *(LAS bf16*)(p + 272) = (bf16)(vv[i].z & 0xffffu); *(LAS bf16*)(p + 340) = (bf16)(vv[i].z >> 16); *(LAS bf16*)(p + 408) = (bf16)(vv[i].w & 0xffffu); *(LAS bf16*)(p + 476) = (bf16)(vv[i].w >> 16); } }
    {   const float QS = 0.08838834764831845f * LOG2E;
        const int sub = lane >> 4, l16 = lane & 15;
        float gq[8], gk[8];
        {   const f32x4 a0 = *(const GAS f32x4*)(a.in[I_QNG] + (size_t)l * 128 + 8 * l16), a1 = *(const GAS f32x4*)(a.in[I_QNG] + (size_t)l * 128 + 8 * l16 + 4);
            const f32x4 b0 = *(const GAS f32x4*)(a.in[I_KNG] + (size_t)l * 128 + 8 * l16), b1 = *(const GAS f32x4*)(a.in[I_KNG] + (size_t)l * 128 + 8 * l16 + 4);
#pragma unroll
            for (int e = 0; e < 4; ++e) { gq[e] = a0[e] * QS; gq[4 + e] = a1[e] * QS; gk[e] = b0[e]; gk[4 + e] = b1[e]; } }
        v4u raw[12];
#pragma unroll
        for (int gi = 0; gi < 12; ++gi) { const int isk = gi / 6, idx = (gi % 6) * 4 + sub, i = idx / 6, h = idx % 6;
            raw[gi] = *(const GAS v4u*)(HZ + (m0 + wave * 4 + i) * NHZ + (isk ? HC_FK : HC_Q) + 128 * h + 8 * l16); }
#pragma unroll
        for (int gi = 0; gi < 12; ++gi) { const int isk = gi / 6, idx = (gi % 6) * 4 + sub, i = idx / 6, h = idx % 6;
            float x[8]; unpack8(raw[gi], x);
            float ssq = 0.f;
#pragma unroll
            for (int e = 0; e < 8; ++e) ssq += x[e] * x[e];
            const float r = __builtin_amdgcn_rsqf(row16_sum(ssq) * (1.0f / 128.0f) + 1e-6f);
            v4u o;
            if (isk) { o.x = pk2(x[0] * r * gk[0], x[1] * r * gk[1]); o.y = pk2(x[2] * r * gk[2], x[3] * r * gk[3]); o.z = pk2(x[4] * r * gk[4], x[5] * r * gk[5]); o.w = pk2(x[6] * r * gk[6], x[7] * r * gk[7]); }
            else { o.x = pk2(x[0] * r * gq[0], x[1] * r * gq[1]); o.y = pk2(x[2] * r * gq[2], x[3] * r * gq[3]); o.z = pk2(x[4] * r * gq[4], x[5] * r * gq[5]); o.w = pk2(x[6] * r * gq[6], x[7] * r * gq[7]); }
            const size_t oo = ((size_t)(b * 6 + h) * SEQ + t0 + wave * 4 + i) * 128 + 8 * l16;
            *(GAS v4u*)((isk ? KF : QF) + oo) = o; } }
    __syncthreads();
#pragma unroll
    for (int j = 0; j < 6; ++j) { const int cidx = tid + 512 * j, d = cidx >> 2, part = cidx & 3; const LAS unsigned* sp = (const LAS unsigned*)(lds + d * 68 + part * 16);
        v4u o; o.x = sp[0]; o.y = sp[1]; o.z = sp[2]; o.w = sp[3];
        *(GAS v4u*)(VT + ((size_t)b * 768 + d) * SEQ + t0 + 8 * part) = o; }
    __syncthreads();
}
__device__ __forceinline__ void fox_bias_unit(const Args& a, int l, int u, LAS unsigned char* lds, int tid, int wave, int lane) {
    const bf16* HZ = (const bf16*)(a.ws + WS_HZ);
    const int b = u / 6, h = u % 6;
    const float fb = a.in[I_FB][l * 6 + h];
    LAS float* wtot = (LAS float*)lds;
    float v[8]; float run = 0.f;
#pragma unroll
    for (int i = 0; i < 8; ++i) { const float x = bf2f(HZ[((size_t)b * SEQ + 8 * tid + i) * NHZ + HC_FF + h]) + fb; run += -softplusf(-x); v[i] = run; }
    float inc = run;
#pragma unroll
    for (int o = 1; o < 64; o <<= 1) { const float t = __shfl_up(inc, o); if (lane >= o) inc += t; }
    if (lane == 63) wtot[wave] = inc;
    __syncthreads();
    float base = inc - run;
    for (int w = 0; w < wave; ++w) base += wtot[w];
    float* bias = (float*)(a.ws + WS_BIAS) + (size_t)u * SEQ + 8 * tid;
#pragma unroll
    for (int i = 0; i < 8; ++i) bias[i] = -(base + v[i]) * LOG2E;
    __syncthreads();
}
#define SWZ(row, chunk) ((row) * 512 + ((((chunk) ^ ((row) & 15))) << 4))
#define SW64(row, chunk) ((row) * 128 + ((((chunk) ^ (((row) >> 1) & 7))) << 4))
constexpr int CL_RT = 0, CL_AT = 8192, CL_BH = 16384, CL_KH = 24576, CL_AAK = 32768, CL_BBT = 40960, CL_KBT = 49152, CL_VT = 57344, CL_ARB = 65536, CL_ARK = 73728,
              CL_XR = 81920  , CL_AABT = 114688  , CL_TOT = 114688,
              CL_W1T = 8192, CL_W2T = 16384  , CL_GT = 131072 + 1024;
__device__ __forceinline__ bf16x8 lds_frag(LAS unsigned char* base, int row, int chunk) { return *(const LAS bf16x8*)(base + SW64(row, chunk)); }

__device__ __forceinline__ void rwkv_chunk_unit(const Args& a, int l, int u, LAS unsigned char* lds, int tid, int wave, int lane) {
    asm volatile("" : "+v"(tid), "+v"(lane));
    const int bh = u >> 6, c = u & 63, b = bh / RH, h = bh % RH;
    const int ch = tid & 63, tq = tid >> 6, fr = lane & 15, fq = lane >> 4;
    const bf16* HZ = (const bf16*)(a.ws + WS_HZ);
    const float* mu = a.in[I_MU] + (size_t)l * 2560;
    const int mb = b * SEQ + 64 * c;
    bf16x8 wfA[8], wfB[8]; float rr[9], kr[9], vr[9];
    {   const bf16* WLT = (const bf16*)(a.ws + WS_WLT) + (size_t)l * RW * 256;
        const bf16* wpA = WLT + (size_t)(64 * h + 16 * (2 * (wave & 1)) + fr) * 256 + 8 * fq; const bf16* wpB = wpA + 16 * 256;
#pragma unroll
        for (int ks = 0; ks < 8; ++ks) { wfA[ks] = *(const GAS bf16x8*)(wpA + 32 * ks); wfB[ks] = *(const GAS bf16x8*)(wpB + 32 * ks); }
        const int m0 = mb + 8 * tq; const bool first = (m0 & (SEQ - 1)) == 0; const bf16* p = HZ + (size_t)(m0 - 1) * NHZ + 64 * h + ch;
        rr[0] = 0.f; kr[0] = 0.f; vr[0] = 0.f; if (!first) { rr[0] = bf2f(p[0]); kr[0] = bf2f(p[768]); vr[0] = bf2f(p[1536]); }
#pragma unroll
        for (int i = 1; i < 9; ++i) { const bf16* q = p + (size_t)i * NHZ; rr[i] = bf2f(q[0]); kr[i] = bf2f(q[768]); vr[i] = bf2f(q[1536]); } }
    {   const int t = tid >> 3, j0 = (tid & 7) * 32; const int m = mb + t; const bool first = (m & (SEQ - 1)) == 0;
        const bool zid = (j0 >= 64 && j0 < 128); const float za = j0 < 64 ? 2.0f : 1.0f, zb = za, zc = j0 < 64 ? -1.0f : 0.0f;
        const bf16* cur = HZ + (size_t)m * NHZ + HC_WD + j0; const bf16* prv = cur - NHZ;
#pragma unroll
        for (int q = 0; q < 4; ++q) { float z[8], zcur[8], zprv[8];
            unpack8(*(const GAS v4u*)(cur + 8 * q), zcur); v4u pw = (v4u){0u, 0u, 0u, 0u}; if (!first) pw = *(const GAS v4u*)(prv + 8 * q); unpack8(pw, zprv);
#pragma unroll
            for (int e = 0; e < 8; ++e) z[e] = zcur[e] + (zprv[e] - zcur[e]) * mu[HC_WD + j0 + 8 * q + e];
#pragma unroll
            for (int e = 0; e < 8; ++e) { const float sg = __builtin_amdgcn_rcpf(1.0f + __expf(-zb * z[e])); z[e] = zid ? z[e] : za * sg + zc; }
            v4u o; o.x = pk2(z[0], z[1]); o.y = pk2(z[2], z[3]); o.z = pk2(z[4], z[5]); o.w = pk2(z[6], z[7]);
            *(LAS v4u*)(lds + SWZ(t, (j0 >> 3) + q)) = o; } }
    __syncthreads();
    {   const int tb = wave >> 1;
        bf16x8 zf[8];
#pragma unroll
        for (int ks = 0; ks < 8; ++ks) zf[ks] = *(const LAS bf16x8*)(lds + SWZ(16 * tb + fr, 4 * ks + fq));
#pragma unroll
        for (int j = 0; j < 2; ++j) { const int cb = 2 * (wave & 1) + j;
            f32x4 aw = (f32x4){0.f, 0.f, 0.f, 0.f}, aa = aw, ag = aw;
#pragma unroll
            for (int ks = 0; ks < 8; ++ks) { const bf16x8 w_ = j ? wfB[ks] : wfA[ks];
                if (ks < 2) aw = __builtin_amdgcn_mfma_f32_16x16x32_bf16(zf[ks], w_, aw, 0, 0, 0);
                else if (ks < 4) aa = __builtin_amdgcn_mfma_f32_16x16x32_bf16(zf[ks], w_, aa, 0, 0, 0);
                else ag = __builtin_amdgcn_mfma_f32_16x16x32_bf16(zf[ks], w_, ag, 0, 0, 0); }
            LAS float* L = (LAS float*)(lds + 32768);
#pragma unroll
            for (int i = 0; i < 4; ++i) { const int o = (16 * tb + 4 * fq + i) * 64 + 16 * cb + fr; L[o] = aw[i]; L[4096 + o] = aa[i]; L[8192 + o] = ag[i]; } } }
    __syncthreads();
    float r[8], lw[8], k[8], v[8], kk[8], bb[8];
    {   const int cc = 64 * h + ch; const int m0 = mb + 8 * tq;
        const float a0 = a.in[I_A0][(size_t)l * RW + cc], w0 = a.in[I_W0][(size_t)l * RW + cc], kkc = a.in[I_KK][(size_t)l * RW + cc], kac = a.in[I_KA][(size_t)l * RW + cc], rkc = a.in[I_RK][(size_t)l * RW + cc];
        const float mr = mu[cc], mk = mu[768 + cc], mv = mu[1536 + cc];
        const LAS float* L = (const LAS float*)(lds + 32768);
        bf16* VBp = (bf16*)(a.ws + WS_VB); bf16* GBp = (bf16*)(a.ws + WS_GB); float* BSp = (float*)(a.ws + WS_BS);
        bf16* vbp = VBp + (size_t)m0 * RW + cc; bf16* gbp = GBp + (size_t)m0 * RW + cc; const LAS float* lp = L + (8 * tq) * 64 + ch;
#pragma unroll
        for (int i = 0; i < 8; ++i) {
            r[i] = rr[i + 1] + (rr[i] - rr[i + 1]) * mr; const float k_ = kr[i + 1] + (kr[i] - kr[i + 1]) * mk; v[i] = vr[i + 1] + (vr[i] - vr[i + 1]) * mv;
            const float aw = lp[0], aa = lp[4096], ag = lp[8192];
            const float av = fast_sigmoid(aa + a0); lw[i] = -__expf(-fast_softplus(-(aw + w0)) - 0.5f);
            const float q_ = k_ * kkc; const float rn = __builtin_amdgcn_rsqf(fmaxf(wave_sum(q_ * q_), 1e-24f));
            kk[i] = q_ * rn; bb[i] = kk[i] * av; k[i] = k_ * (1.0f + (av - 1.0f) * kac);
            const float bs = wave_sum(r[i] * k[i] * rkc);
            *vbp = (bf16)f2bf(v[i]); *gbp = (bf16)f2bf(ag);
            if (ch == 0) BSp[(size_t)(m0 + i) * RH + h] = bs;
            vbp += RW; gbp += RW; lp += 64;
            asm volatile("" : "+v"(vbp), "+v"(gbp)); } }
    float cum[8]; { float run = 0.f;
#pragma unroll
        for (int i = 0; i < 8; ++i) { run += lw[i]; cum[i] = run; }
        ((LAS float*)(lds + CL_TOT))[tq * 64 + ch] = run; }
    __syncthreads();
    float off = 0.f, tot = 0.f;
#pragma unroll
    for (int j = 0; j < 8; ++j) { const float t = ((LAS float*)(lds + CL_TOT))[j * 64 + ch]; tot += t; if (j < tq) off += t; }
    if (tq == 0) ((LAS float*)(lds + CL_GT))[ch] = __expf(tot);
    {   v4u wb, wk, wv;
        unsigned short hb[8], hk[8], hv[8];
#pragma unroll
        for (int i = 0; i < 8; ++i) { const int t = 8 * tq + i; const float cu = off + cum[i];
            const float g = __expf(cu), ge = __expf(cu - lw[i]), ig = __expf(-cu), gc = __expf(tot - cu);
            const float at = -kk[i] * ge;
            const int ro = SW64(t, ch >> 3) + (ch & 7) * 2;
            *(LAS bf16*)(lds + CL_RT + ro) = (bf16)f2bf(r[i] * g);
            *(LAS bf16*)(lds + CL_AT + ro) = (bf16)f2bf(at);
            *(LAS bf16*)(lds + CL_BH + ro) = (bf16)f2bf(bb[i] * ig);
            *(LAS bf16*)(lds + CL_KH + ro) = (bf16)f2bf(k[i] * ig);
            ((LAS float*)(lds + CL_XR))[t * 128 + ch] = at;
            hb[i] = (unsigned short)f2bf(bb[i] * gc); hk[i] = (unsigned short)f2bf(k[i] * gc); hv[i] = (unsigned short)f2bf(v[i]); }
        wb.x = hb[0] | (hb[1] << 16); wb.y = hb[2] | (hb[3] << 16); wb.z = hb[4] | (hb[5] << 16); wb.w = hb[6] | (hb[7] << 16);
        wk.x = hk[0] | (hk[1] << 16); wk.y = hk[2] | (hk[3] << 16); wk.z = hk[4] | (hk[5] << 16); wk.w = hk[6] | (hk[7] << 16);
        wv.x = hv[0] | (hv[1] << 16); wv.y = hv[2] | (hv[3] << 16); wv.z = hv[4] | (hv[5] << 16); wv.w = hv[6] | (hv[7] << 16);
        *(LAS v4u*)(lds + CL_BBT + SW64(ch, tq)) = wb; *(LAS v4u*)(lds + CL_KBT + SW64(ch, tq)) = wk; *(LAS v4u*)(lds + CL_VT + SW64(ch, tq)) = wv; }
    __syncthreads();
    {   const int mat = wave & 3;
        LAS unsigned char* X = lds + ((mat < 2) ? CL_AT : CL_RT); LAS unsigned char* Yo = lds + ((mat & 1) ? CL_KH : CL_BH);
        LAS unsigned char* Out = lds + (mat == 1 ? CL_AAK : (mat == 2 ? CL_ARB : CL_ARK));
#pragma unroll
        for (int rbi = 0; rbi < 2; ++rbi) { const int rb = 2 * (wave >> 2) + rbi;
            const bf16x8 x0 = lds_frag(X, 16 * rb + fr, fq), x1 = lds_frag(X, 16 * rb + fr, 4 + fq);
#pragma unroll
            for (int cb = 0; cb < 4; ++cb) {
                f32x4 acc = (f32x4){0.f, 0.f, 0.f, 0.f};
                if (cb <= rb) { acc = __builtin_amdgcn_mfma_f32_16x16x32_bf16(x0, lds_frag(Yo, 16 * cb + fr, fq), acc, 0, 0, 0);
                                acc = __builtin_amdgcn_mfma_f32_16x16x32_bf16(x1, lds_frag(Yo, 16 * cb + fr, 4 + fq), acc, 0, 0, 0); }
                const int sidx = 16 * cb + fr;
#pragma unroll
                for (int i = 0; i < 4; ++i) { const int t = 16 * rb + 4 * fq + i; const bool keep = (mat < 2) ? (sidx < t) : (sidx <= t); const float val = keep ? acc[i] : 0.f;
                    if (mat == 0) ((LAS float*)(lds + CL_AABT))[sidx * 64 + t] = val;
                    else *(LAS bf16*)(Out + SW64(t, sidx >> 3) + (sidx & 7) * 2) = (bf16)f2bf(val); } } } }
    __syncthreads();
    {   const int tb = wave >> 1;
        const bf16x8 x0 = lds_frag(lds + CL_AAK, 16 * tb + fr, fq), x1 = lds_frag(lds + CL_AAK, 16 * tb + fr, 4 + fq);
#pragma unroll
        for (int j = 0; j < 2; ++j) { const int vb = 2 * (wave & 1) + j; f32x4 acc = (f32x4){0.f, 0.f, 0.f, 0.f};
            acc = __builtin_amdgcn_mfma_f32_16x16x32_bf16(x0, lds_frag(lds + CL_VT, 16 * vb + fr, fq), acc, 0, 0, 0);
            acc = __builtin_amdgcn_mfma_f32_16x16x32_bf16(x1, lds_frag(lds + CL_VT, 16 * vb + fr, 4 + fq), acc, 0, 0, 0);
#pragma unroll
            for (int i = 0; i < 4; ++i) ((LAS float*)(lds + CL_XR))[(16 * tb + 4 * fq + i) * 128 + 64 + 16 * vb + fr] = acc[i]; } }
    __syncthreads();
    {   const LAS float* At = (const LAS float*)(lds + CL_AABT);
        LAS unsigned char* scr = lds + CL_KH + wave * 2048;
        bf16x8 tf[4];
        {   const int tb_ = lane >> 4, j = lane & 15; const LAS float* Ab = At + (16 * tb_) * 64 + 16 * tb_;
            float T[16];
#pragma unroll
            for (int t = 0; t < 16; ++t) { float acc = (t == j) ? 1.0f : 0.0f;
#pragma unroll
                for (int sI = 0; sI < t; ++sI) acc += Ab[sI * 64 + t] * T[sI];
                T[t] = acc; if ((t & 3) == 3) __builtin_amdgcn_sched_barrier(0); }
#pragma unroll
            for (int t = 0; t < 16; ++t) *(LAS bf16*)(scr + tb_ * 512 + t * 32 + j * 2) = (bf16)f2bf(T[t]);
            LDS_WAIT(); asm volatile("" ::: "memory");
#pragma unroll
            for (int b4 = 0; b4 < 4; ++b4) { v4u z4 = (v4u){0u, 0u, 0u, 0u}; if (fq < 2) z4 = *(const LAS v4u*)(scr + b4 * 512 + fr * 32 + fq * 16); tf[b4] = __builtin_bit_cast(bf16x8, z4); }
            LDS_WAIT(); asm volatile("" ::: "memory"); }
        const int ncol = 16 * wave + fr;
        LAS unsigned char* Wt = lds + (wave < 4 ? CL_W1T : CL_W2T); const int nrow = (ncol & 63);
        const LAS float* XRp = (const LAS float*)(lds + CL_XR) + ncol;
#pragma unroll
        for (int b4 = 0; b4 < 4; ++b4) {
            f32x4 acc;
#pragma unroll
            for (int i = 0; i < 4; ++i) acc[i] = XRp[(16 * b4 + 4 * fq + i) * 128];
#pragma unroll
            for (int ks = 0; ks < 2; ++ks) if (32 * ks < 16 * b4) {
                float av[8];
#pragma unroll
                for (int e = 0; e < 8; ++e) { const int sI = 32 * ks + 8 * fq + e; av[e] = (sI < 16 * b4) ? At[sI * 64 + 16 * b4 + fr] : 0.f; }
                v4u aw; aw.x = pk2(av[0], av[1]); aw.y = pk2(av[2], av[3]); aw.z = pk2(av[4], av[5]); aw.w = pk2(av[6], av[7]);
                const bf16x8 xf = *(const LAS bf16x8*)(Wt + SW64(nrow, 4 * ks + fq));
                v4u xm = __builtin_bit_cast(v4u, xf);
                if (32 * ks + 8 * fq >= 16 * b4) xm = (v4u){0u, 0u, 0u, 0u};
                acc = __builtin_amdgcn_mfma_f32_16x16x32_bf16(__builtin_bit_cast(bf16x8, aw), __builtin_bit_cast(bf16x8, xm), acc, 0, 0, 0); }
#pragma unroll
            for (int i = 0; i < 4; ++i) *(LAS bf16*)(scr + fr * 32 + (4 * fq + i) * 2) = (bf16)f2bf(acc[i]);
            LDS_WAIT(); asm volatile("" ::: "memory");
            v4u rz = (v4u){0u, 0u, 0u, 0u}; if (fq < 2) rz = *(const LAS v4u*)(scr + fr * 32 + fq * 16);
            LDS_WAIT(); asm volatile("" ::: "memory");
            f32x4 xb = __builtin_amdgcn_mfma_f32_16x16x32_bf16(tf[b4], __builtin_bit_cast(bf16x8, rz), (f32x4){0.f, 0.f, 0.f, 0.f}, 0, 0, 0);
            v2u o; o.x = pk2(xb[0], xb[1]); o.y = pk2(xb[2], xb[3]);
            const int s0 = 16 * b4 + 4 * fq;
            *(LAS v2u*)(Wt + SW64(nrow, s0 >> 3) + (s0 & 7) * 2) = o;
            LDS_WAIT(); asm volatile("" ::: "memory");
            __builtin_amdgcn_sched_barrier(0);
        }
    }
    __syncthreads();
    {   const int job = wave >> 1;
        LAS unsigned char* A1 = lds + (job == 0 ? CL_W1T : job == 1 ? CL_ARB : job == 2 ? CL_W1T : CL_BBT);
        LAS unsigned char* B1 = lds + (job == 0 ? CL_ARB : job == 1 ? CL_W2T : job == 2 ? CL_BBT : CL_W2T);
        LAS unsigned char* A2 = lds + (job == 1 ? CL_ARK : CL_KBT);
        LAS unsigned char* B2 = lds + (job == 1 ? CL_VT : CL_VT);
        unsigned char* ws = a.ws;
#pragma unroll
        for (int rbi = 0; rbi < 2; ++rbi) { const int rb = 2 * (wave & 1) + rbi;
            const bf16x8 x0 = lds_frag(A1, 16 * rb + fr, fq), x1 = lds_frag(A1, 16 * rb + fr, 4 + fq);
            bf16x8 y0 = x0, y1 = x1; if (job & 1) { y0 = lds_frag(A2, 16 * rb + fr, fq); y1 = lds_frag(A2, 16 * rb + fr, 4 + fq); }
#pragma unroll
            for (int cb = 0; cb < 4; ++cb) { f32x4 acc = (f32x4){0.f, 0.f, 0.f, 0.f};
                acc = __builtin_amdgcn_mfma_f32_16x16x32_bf16(x0, lds_frag(B1, 16 * cb + fr, fq), acc, 0, 0, 0);
                acc = __builtin_amdgcn_mfma_f32_16x16x32_bf16(x1, lds_frag(B1, 16 * cb + fr, 4 + fq), acc, 0, 0, 0);
                if (job & 1) { acc = __builtin_amdgcn_mfma_f32_16x16x32_bf16(y0, lds_frag(B2, 16 * cb + fr, fq), acc, 0, 0, 0);
                               acc = __builtin_amdgcn_mfma_f32_16x16x32_bf16(y1, lds_frag(B2, 16 * cb + fr, 4 + fq), acc, 0, 0, 0); }
                if (job == 0) {
                    const int t = 16 * cb + fr, k0 = 16 * rb + 4 * fq; const v2u rt = *(const LAS v2u*)(lds + CL_RT + SW64(t, k0 >> 3) + (k0 & 7) * 2);
                    v2u o; o.x = pk2(acc[0] + __uint_as_float(rt.x << 16), acc[1] + __uint_as_float(rt.x & 0xffff0000u)); o.y = pk2(acc[2] + __uint_as_float(rt.y << 16), acc[3] + __uint_as_float(rt.y & 0xffff0000u));
                    *(GAS v2u*)((bf16*)(ws + WS_CHR2) + ((size_t)u * 64 + t) * 64 + k0) = o;
                } else if (job == 2) {
                    const int kr = 16 * cb + fr, k0 = 16 * rb + 4 * fq; const float gc = ((const LAS float*)(lds + CL_GT))[kr];
                    v2u o; o.x = pk2(acc[0] + (kr == k0 ? gc : 0.f), acc[1] + (kr == k0 + 1 ? gc : 0.f)); o.y = pk2(acc[2] + (kr == k0 + 2 ? gc : 0.f), acc[3] + (kr == k0 + 3 ? gc : 0.f));
                    *(GAS v2u*)((bf16*)(ws + WS_CHP) + ((size_t)u * 64 + kr) * 64 + ((rb >> 1) * 32 + fq * 8 + (rb & 1) * 4)) = o;
                } else {
                    if (job == 1) *(GAS f32x4*)((float*)(ws + WS_CHY0) + (((size_t)u * 4 + rb) * 4 + cb) * 256 + lane * 4) = acc;
                    else *(GAS f32x4*)((float*)(ws + WS_CHQ) + (((size_t)u * 4 + cb) * 4 + rb) * 256 + lane * 4) = acc; } } } }
    __syncthreads();
}
__device__ __forceinline__ void rwkv_state_unit(const Args& a, int bh, int vb, LAS unsigned char* lds, int wave, int lane) {
    if (wave != 0) return;
    const int fr = lane & 15, fq = lane >> 4;
    const bf16* P = (const bf16*)(a.ws + WS_CHP) + (size_t)bh * 64 * 4096; const float* Q = (const float*)(a.ws + WS_CHQ) + (size_t)bh * 64 * 4096; bf16* HS = (bf16*)(a.ws + WS_CHHS) + (size_t)bh * 64 * 4096;
    v4u hB[2]; hB[0] = (v4u){0u, 0u, 0u, 0u}; hB[1] = hB[0];
    bf16x8 pfA[4][2], pfB[4][2], pfC[4][2]; f32x4 qfA[4], qfB[4], qfC[4];
#define ST_LOAD(pf, qf, cc) do { _Pragma("unroll") for (int kb = 0; kb < 4; ++kb) { _Pragma("unroll") for (int ks = 0; ks < 2; ++ks) pf[kb][ks] = *(const GAS bf16x8*)(P + ((size_t)(cc) * 64 + 16 * kb + fr) * 64 + 32 * ks + 8 * fq); \
        qf[kb] = *(const GAS f32x4*)(Q + (((size_t)(cc) * 4 + vb) * 4 + kb) * 256 + lane * 4); } } while (0)
#define ST_STEP(pf, qf, cc) do { \
        _Pragma("unroll") for (int ks = 0; ks < 2; ++ks) { v2u lo_, hi_; lo_.x = hB[ks].x; lo_.y = hB[ks].y; hi_.x = hB[ks].z; hi_.y = hB[ks].w; \
            *(GAS v2u*)(HS + ((size_t)(cc) * 64 + 16 * vb + fr) * 64 + 16 * (2 * ks) + 4 * fq) = lo_; *(GAS v2u*)(HS + ((size_t)(cc) * 64 + 16 * vb + fr) * 64 + 16 * (2 * ks + 1) + 4 * fq) = hi_; } \
        f32x4 acc[4]; \
        _Pragma("unroll") for (int kb = 0; kb < 4; ++kb) { acc[kb] = qf[kb]; \
            _Pragma("unroll") for (int ks = 0; ks < 2; ++ks) acc[kb] = __builtin_amdgcn_mfma_f32_16x16x32_bf16(pf[kb][ks], __builtin_bit_cast(bf16x8, hB[ks]), acc[kb], 0, 0, 0); } \
        ST_LOAD(pf, qf, ((cc) + 3 < 64 ? (cc) + 3 : 63)); \
        _Pragma("unroll") for (int ks = 0; ks < 2; ++ks) { hB[ks].x = pk2(acc[2 * ks][0], acc[2 * ks][1]); hB[ks].y = pk2(acc[2 * ks][2], acc[2 * ks][3]); \
            hB[ks].z = pk2(acc[2 * ks + 1][0], acc[2 * ks + 1][1]); hB[ks].w = pk2(acc[2 * ks + 1][2], acc[2 * ks + 1][3]); } } while (0)
    __builtin_amdgcn_s_waitcnt(0);
    ST_LOAD(pfA, qfA, 0); ST_LOAD(pfB, qfB, 1); ST_LOAD(pfC, qfC, 2);
#pragma unroll 1
    for (int c = 0; c < 63; c += 3) { ST_STEP(pfA, qfA, c); ST_STEP(pfB, qfB, c + 1); ST_STEP(pfC, qfC, c + 2); }
    {   _Pragma("unroll") for (int ks = 0; ks < 2; ++ks) { v2u lo_, hi_; lo_.x = hB[ks].x; lo_.y = hB[ks].y; hi_.x = hB[ks].z; hi_.y = hB[ks].w;
            *(GAS v2u*)(HS + ((size_t)63 * 64 + 16 * vb + fr) * 64 + 16 * (2 * ks) + 4 * fq) = lo_; *(GAS v2u*)(HS + ((size_t)63 * 64 + 16 * vb + fr) * 64 + 16 * (2 * ks + 1) + 4 * fq) = hi_; } }
#undef ST_LOAD
#undef ST_STEP
}
__device__ __forceinline__ void rwkv_out_pass(const Args& a, int l, int gw, int ngw, int lane) {
    const int fr = lane & 15, fq = lane >> 4;
    const bf16* VBp = (const bf16*)(a.ws + WS_VB); const bf16* GBp = (const bf16*)(a.ws + WS_GB); const float* BSp = (const float*)(a.ws + WS_BS); bf16* OB = (bf16*)(a.ws + WS_OB);
    for (int it = gw; it < 1536 * 4; it += ngw) { const int u = it >> 2, tb = it & 3, bh = u >> 6, c = u & 63, b = bh / RH, h = bh % RH;
        const bf16* R2 = (const bf16*)(a.ws + WS_CHR2) + (size_t)u * 4096; const bf16* HS = (const bf16*)(a.ws + WS_CHHS) + (size_t)u * 4096; const float* Y0 = (const float*)(a.ws + WS_CHY0) + ((size_t)u * 4 + tb) * 1024;
        const bf16x8 r0 = *(const GAS bf16x8*)(R2 + (16 * tb + fr) * 64 + 8 * fq), r1 = *(const GAS bf16x8*)(R2 + (16 * tb + fr) * 64 + 32 + 8 * fq);
        const int m0 = b * SEQ + 64 * c + 16 * tb + 4 * fq;
        f32x4 y[4]; bf16x8 hf[4][2]; bf16 vv_[4][4], gg_[4][4]; float bs_[4];
#pragma unroll
        for (int vb = 0; vb < 4; ++vb) { y[vb] = *(const GAS f32x4*)(Y0 + vb * 256 + lane * 4); hf[vb][0] = *(const GAS bf16x8*)(HS + (16 * vb + fr) * 64 + 8 * fq); hf[vb][1] = *(const GAS bf16x8*)(HS + (16 * vb + fr) * 64 + 32 + 8 * fq); }
#pragma unroll
        for (int i = 0; i < 4; ++i) { bs_[i] = BSp[(size_t)(m0 + i) * RH + h];
#pragma unroll
            for (int vb = 0; vb < 4; ++vb) { const size_t o = (size_t)(m0 + i) * RW + 64 * h + 16 * vb + fr; vv_[i][vb] = VBp[o]; gg_[i][vb] = GBp[o]; } }
#pragma unroll
        for (int vb = 0; vb < 4; ++vb) { y[vb] = __builtin_amdgcn_mfma_f32_16x16x32_bf16(r0, hf[vb][0], y[vb], 0, 0, 0); y[vb] = __builtin_amdgcn_mfma_f32_16x16x32_bf16(r1, hf[vb][1], y[vb], 0, 0, 0); }
        float lg[4], lb[4];
#pragma unroll
        for (int vb = 0; vb < 4; ++vb) { lg[vb] = a.in[I_LNXG][(size_t)l * RW + 64 * h + 16 * vb + fr]; lb[vb] = a.in[I_LNXB][(size_t)l * RW + 64 * h + 16 * vb + fr]; }
#pragma unroll
        for (int i = 0; i < 4; ++i) { const int m = m0 + i;
            const float mu = row16_sum((y[0][i] + y[1][i]) + (y[2][i] + y[3][i])) * (1.0f / 64.0f);
            float d[4]; float q = 0.f;
#pragma unroll
            for (int vb = 0; vb < 4; ++vb) { d[vb] = y[vb][i] - mu; q += d[vb] * d[vb]; }
            const float rstd = __builtin_amdgcn_rsqf(row16_sum(q) * (1.0f / 64.0f) + 64e-5f);
#pragma unroll
            for (int vb = 0; vb < 4; ++vb) { const float vv = __uint_as_float(((unsigned)vv_[i][vb]) << 16), gg = __uint_as_float(((unsigned)gg_[i][vb]) << 16);
                OB[(size_t)m * D + 64 * h + 16 * vb + fr] = (bf16)f2bf((d[vb] * rstd * lg[vb] + lb[vb] + bs_[i] * vv) * gg); } } }
}
__device__ __forceinline__ void rwkv_post(const Args& a, int l, int gw, int ngw, int lane) {
    const bf16* VBp = (const bf16*)(a.ws + WS_VB); const bf16* GBp = (const bf16*)(a.ws + WS_GB); const float* BSp = (const float*)(a.ws + WS_BS);
    const float* Y = (const float*)(a.ws + WS_Y); bf16* OB = (bf16*)(a.ws + WS_OB);
    for (int i = gw; i < M * RH; i += ngw) { const int m = i / RH, h = i % RH; const int c = 64 * h + lane; const size_t o = (size_t)m * RW + c;
        const float y = Y[o]; const float mu = wave_sum(y) * (1.0f / 64.0f); const float d = y - mu; const float var = wave_sum(d * d) * (1.0f / 64.0f);
        const float yn = d * __builtin_amdgcn_rsqf(var + 64e-5f) * a.in[I_LNXG][(size_t)l * RW + c] + a.in[I_LNXB][(size_t)l * RW + c];
        const float bs = BSp[i], vv = __uint_as_float(((unsigned)VBp[o]) << 16), gg = __uint_as_float(((unsigned)GBp[o]) << 16);
        OB[(size_t)m * D + c] = (bf16)f2bf((yn + bs * vv) * gg); }
}

__device__ __forceinline__ void attn_tile(const LAS unsigned char* Kt, const LAS unsigned char* Vt, const f32x4 (&bv)[4], const bf16x8 (&qf)[4], f32x4 (&o)[8], float& mrun, float& lsum,
                                          int kt, int row, int rowmin, int fr, int fq) {
    f32x4 sc[4];
#define AT_KF(dst, kb) do { _Pragma("unroll") for (int ks = 0; ks < 4; ++ks) dst[ks] = *(const LAS bf16x8*)(Kt + (16 * (kb) + fr) * 256 + (((4 * ks + fq) ^ fr) << 4)); } while (0)
    {   bf16x8 kfa[4], kfb[4];
        AT_KF(kfa, 0); AT_KF(kfb, 1);
        __builtin_amdgcn_sched_barrier(0);
#pragma unroll
        for (int ks = 0; ks < 4; ++ks) sc[0] = __builtin_amdgcn_mfma_f32_16x16x32_bf16(kfa[ks], qf[ks], ks ? sc[0] : (f32x4){0.f, 0.f, 0.f, 0.f}, 0, 0, 0);
        __builtin_amdgcn_sched_barrier(0);
        AT_KF(kfa, 2);
        __builtin_amdgcn_sched_barrier(0);
#pragma unroll
        for (int ks = 0; ks < 4; ++ks) sc[1] = __builtin_amdgcn_mfma_f32_16x16x32_bf16(kfb[ks], qf[ks], ks ? sc[1] : (f32x4){0.f, 0.f, 0.f, 0.f}, 0, 0, 0);
        __builtin_amdgcn_sched_barrier(0);
        AT_KF(kfb, 3);
        __builtin_amdgcn_sched_barrier(0);
#pragma unroll
        for (int ks = 0; ks < 4; ++ks) sc[2] = __builtin_amdgcn_mfma_f32_16x16x32_bf16(kfa[ks], qf[ks], ks ? sc[2] : (f32x4){0.f, 0.f, 0.f, 0.f}, 0, 0, 0);
#pragma unroll
        for (int ks = 0; ks < 4; ++ks) sc[3] = __builtin_amdgcn_mfma_f32_16x16x32_bf16(kfb[ks], qf[ks], ks ? sc[3] : (f32x4){0.f, 0.f, 0.f, 0.f}, 0, 0, 0);
        __builtin_amdgcn_sched_barrier(0); }
#undef AT_KF
    const bool diag = (64 * kt + 63 > rowmin);
    float mx = -3.0e38f;
#pragma unroll
    for (int kb = 0; kb < 4; ++kb) { const int j0 = 64 * kt + 32 * (kb >> 1) + 8 * fq + 4 * (kb & 1);
#pragma unroll
        for (int i = 0; i < 4; ++i) { float x = sc[kb][i] + bv[kb][i]; if (diag && (j0 + i > row)) x = -__builtin_inff(); sc[kb][i] = x; mx = fmaxf(mx, x); } }
    mx = fmaxf(mx, __shfl_xor(mx, 16)); mx = fmaxf(mx, __shfl_xor(mx, 32));
    const float mnew = fmaxf(mrun, mx), alpha = __builtin_amdgcn_exp2f(mrun - mnew); mrun = mnew;
    float ps = 0.f;
#pragma unroll
    for (int kb = 0; kb < 4; ++kb)
#pragma unroll
        for (int i = 0; i < 4; ++i) { const float p = __builtin_amdgcn_exp2f(sc[kb][i] - mnew); sc[kb][i] = p; ps += p; }
    lsum = lsum * alpha + ps;
    if (__any(alpha != 1.0f)) {
#pragma unroll
        for (int nb = 0; nb < 8; ++nb) o[nb] = o[nb] * alpha; }
    bf16x8 pf[2];
#pragma unroll
    for (int s2 = 0; s2 < 2; ++s2) { v4u w; w.x = pg8::cvt_pk_bf16(sc[2 * s2][0], sc[2 * s2][1]); w.y = pg8::cvt_pk_bf16(sc[2 * s2][2], sc[2 * s2][3]);
        w.z = pg8::cvt_pk_bf16(sc[2 * s2 + 1][0], sc[2 * s2 + 1][1]); w.w = pg8::cvt_pk_bf16(sc[2 * s2 + 1][2], sc[2 * s2 + 1][3]); pf[s2] = __builtin_bit_cast(bf16x8, w); }
#define AT_VF(dst, nb2) do { _Pragma("unroll") for (int j = 0; j < 2; ++j) { _Pragma("unroll") for (int s2 = 0; s2 < 2; ++s2) { const int d = 16 * (2 * (nb2) + j) + fr; \
        dst[j][s2] = *(const LAS bf16x8*)(Vt + d * 128 + (((4 * s2 + fq) ^ ((d >> 1) & 7)) << 4)); } } } while (0)
#define AT_VM(src, nb2) do { _Pragma("unroll") for (int j = 0; j < 2; ++j) { _Pragma("unroll") for (int s2 = 0; s2 < 2; ++s2) o[2 * (nb2) + j] = __builtin_amdgcn_mfma_f32_16x16x32_bf16(src[j][s2], pf[s2], o[2 * (nb2) + j], 0, 0, 0); } } while (0)
    {   bf16x8 vfa[2][2], vfb[2][2];
        AT_VF(vfa, 0); AT_VF(vfb, 1);
        __builtin_amdgcn_sched_barrier(0);
        AT_VM(vfa, 0);
        __builtin_amdgcn_sched_barrier(0);
        AT_VF(vfa, 2);
        __builtin_amdgcn_sched_barrier(0);
        AT_VM(vfb, 1);
        __builtin_amdgcn_sched_barrier(0);
        AT_VF(vfb, 3);
        __builtin_amdgcn_sched_barrier(0);
        AT_VM(vfa, 2); AT_VM(vfb, 3);
        __builtin_amdgcn_sched_barrier(0); }
#undef AT_VF
#undef AT_VM
}
__device__ __forceinline__ void attn_unit(const Args& a, int l, int bh, int qb, LAS unsigned char* lds, int tid, int wave, int lane) {
    const bf16* Q = (const bf16*)(a.ws + WS_QF) + (size_t)bh * SEQ * 128; const bf16* Kg = (const bf16*)(a.ws + WS_KF) + (size_t)bh * SEQ * 128;
    const bf16* VTg = (const bf16*)(a.ws + WS_VT) + (size_t)bh * 128 * SEQ; const float* bias = (const float*)(a.ws + WS_BIAS) + (size_t)bh * SEQ;
    const int fr = lane & 15, fq = lane >> 4, q0 = qb * 128, rowmin = q0 + 16 * wave, row = rowmin + fr;
    bf16x8 qf[4];
#pragma unroll
    for (int ks = 0; ks < 4; ++ks) qf[ks] = *(const bf16x8*)(Q + (size_t)row * 128 + 32 * ks + 8 * fq);
    float sbound;
    {   float q2 = 0.f;
#pragma unroll
        for (int ks = 0; ks < 4; ++ks)
#pragma unroll
            for (int j = 0; j < 8; ++j) { const float x = __uint_as_float(((unsigned)(unsigned short)qf[ks][j]) << 16); q2 += x * x; }
        q2 += __shfl_xor(q2, 16); q2 += __shfl_xor(q2, 32);
        const float qmax = sqrtf(wave_max(q2));
        const float* kg = a.in[I_KNG] + (size_t)l * 128; const float gmax = wave_max(fmaxf(fabsf(kg[2 * lane]), fabsf(kg[2 * lane + 1])));
        sbound = qmax * (11.313708499f * gmax) * 1.02f; }
    f32x4 o[8];
#pragma unroll
    for (int nb = 0; nb < 8; ++nb) o[nb] = (f32x4){0.f, 0.f, 0.f, 0.f};
    float mrun = -1e30f, lsum = 0.f;
    const int nkt = 2 * (qb + 1);
    int kso[2], vso[2]; const bf16* kgp[2]; const bf16* vgp[2];
#pragma unroll
    for (int i = 0; i < 2; ++i) { const int ci = tid + 512 * i;
        { const int kap = ci >> 4, c = ci & 15, kb = 2 * (kap >> 5) + ((kap >> 2) & 1), rho = 4 * ((kap >> 3) & 3) + (kap & 3); kso[i] = (16 * kb + rho) * 256 + ((c ^ rho) << 4); kgp[i] = Kg + (size_t)kap * 128 + 8 * c; }
        { const int d = ci >> 3, c = ci & 7; vso[i] = d * 128 + ((c ^ ((d >> 1) & 7)) << 4); vgp[i] = VTg + (size_t)d * SEQ + 8 * c; } }
    v4u kst[2], vst[2]; f32x4 bvc[4], bvn[4];
#define AT_LOAD(kt) do { _Pragma("unroll") for (int i = 0; i < 2; ++i) { kst[i] = *(const GAS v4u*)(kgp[i] + (size_t)(kt) * 64 * 128); vst[i] = *(const GAS v4u*)(vgp[i] + (kt) * 64); } } while (0)
#define AT_BIAS(dst, kt) do { _Pragma("unroll") for (int kb = 0; kb < 4; ++kb) dst[kb] = *(const GAS f32x4*)(bias + 64 * (kt) + 32 * (kb >> 1) + 8 * fq + 4 * (kb & 1)); } while (0)
#define AT_STORE(s) do { _Pragma("unroll") for (int i = 0; i < 2; ++i) { *(LAS v4u*)(lds + (s) * 32768 + kso[i]) = kst[i]; *(LAS v4u*)(lds + (s) * 32768 + 16384 + vso[i]) = vst[i]; } } while (0)
    volatile LAS unsigned* dfl = (volatile LAS unsigned*)(lds + MISC_OFF + 128);
    AT_LOAD(nkt - 1); AT_BIAS(bvc, nkt - 1); AT_STORE(0);
    __syncthreads();
    bool wdone = false;
#pragma unroll 1
    for (int it = 0, kt = nkt - 1; kt >= 0; ++it, --kt) {
        const int s = it & 1;
        if (kt > 0) { AT_LOAD(kt - 1); AT_BIAS(bvn, kt - 1); }
        __builtin_amdgcn_sched_barrier(0);
        if (!wdone && 64 * kt <= rowmin + 15) attn_tile(lds + s * 32768, lds + s * 32768 + 16384, bvc, qf, o, mrun, lsum, kt, row, rowmin, fr, fq);
        __builtin_amdgcn_sched_barrier(0);
        if (kt > 0) {
            AT_STORE(s ^ 1);
            if (!wdone) { const float bnext = RDL_F(bvn[3][3], 48);
                wdone = (bnext + sbound - wave_min(mrun) < -40.0f); }
#pragma unroll
            for (int kb = 0; kb < 4; ++kb) bvc[kb] = bvn[kb];
        }
        if (lane == 0) dfl[8 * s + wave] = wdone ? 1u : 0u;
        __syncthreads();
        const unsigned all = dfl[8 * s] & dfl[8 * s + 1] & dfl[8 * s + 2] & dfl[8 * s + 3] & dfl[8 * s + 4] & dfl[8 * s + 5] & dfl[8 * s + 6] & dfl[8 * s + 7];
        if (all) break;
    }
#undef AT_LOAD
#undef AT_BIAS
#undef AT_STORE
    __syncthreads();
    lsum += __shfl_xor(lsum, 16); lsum += __shfl_xor(lsum, 32);
    const float inv = 1.0f / lsum;
    bf16* OB = (bf16*)(a.ws + WS_OB);
    const int b = bh / FH, h = bh % FH;
    bf16* dst = OB + ((size_t)b * SEQ + row) * D + 768 + 128 * h + 4 * fq;
#pragma unroll
    for (int nb = 0; nb < 8; ++nb) { v2u w; w.x = pk2(o[nb][0] * inv, o[nb][1] * inv); w.y = pk2(o[nb][2] * inv, o[nb][3] * inv); *(GAS v2u*)(dst + 16 * nb) = w; }
}

struct MoeTiles { int t[9]; };
__device__ __forceinline__ void moe_tile_bases(const Args& a, int& t1, int& t2, int& t3, int& t4, int& t5, int& t6, int& t7, int& t8) {
    unsigned* cnt = (unsigned*)(a.ws + WS_CTL) + CW_CNT;
    int acc = 0;
    acc += ((int)xb_ld(cnt + 64 * 0) + 255) >> 8; t1 = acc; acc += ((int)xb_ld(cnt + 64 * 1) + 255) >> 8; t2 = acc; acc += ((int)xb_ld(cnt + 64 * 2) + 255) >> 8; t3 = acc;
    acc += ((int)xb_ld(cnt + 64 * 3) + 255) >> 8; t4 = acc; acc += ((int)xb_ld(cnt + 64 * 4) + 255) >> 8; t5 = acc; acc += ((int)xb_ld(cnt + 64 * 5) + 255) >> 8; t6 = acc;
    acc += ((int)xb_ld(cnt + 64 * 6) + 255) >> 8; t7 = acc; acc += ((int)xb_ld(cnt + 64 * 7) + 255) >> 8; t8 = acc;
}
__device__ __forceinline__ int moe_sk_full(int t8, int G) { const int total = t8 * 8; int full = (total / G) * G; full -= full % 8; if (total - full > 64) full = total; return full; }
__device__ __forceinline__ void moe_combine(const Args& a, const float* modl, int gw, int ngw, int lane) {
    unsigned char* tk = a.ws + WS_TOK; const bf16* X1 = (const bf16*)(a.ws + WS_X1); const bf16* YB = (const bf16*)(a.ws + WS_YB); const bf16* YB2 = (const bf16*)(a.ws + WS_YB2);
    int t1, t2, t3, t4, t5, t6, t7, t8; moe_tile_bases(a, t1, t2, t3, t4, t5, t6, t7, t8);
    const int rt = (moe_sk_full(t8, (int)gridDim.x) >> 3) * 256;
#define CMB_META(mm, P0_, P1_, G0_, G1_) do { const int e0_ = ((const int*)(tk + TK_EXP))[mm], e1_ = ((const int*)(tk + TK_EXP))[8192 + (mm)]; \
        const int tb0_ = e0_ == 0 ? 0 : (e0_ == 1 ? t1 : e0_ == 2 ? t2 : e0_ == 3 ? t3 : e0_ == 4 ? t4 : e0_ == 5 ? t5 : e0_ == 6 ? t6 : t7); \
        const int tb1_ = e1_ == 0 ? 0 : (e1_ == 1 ? t1 : e1_ == 2 ? t2 : e1_ == 3 ? t3 : e1_ == 4 ? t4 : e1_ == 5 ? t5 : e1_ == 6 ? t6 : t7); \
        P0_ = tb0_ * 256 + ((const int*)(tk + TK_RANK))[mm]; P1_ = tb1_ * 256 + ((const int*)(tk + TK_RANK))[8192 + (mm)]; \
        G0_ = ((const float*)(tk + TK_GATE))[mm]; G1_ = ((const float*)(tk + TK_GATE))[8192 + (mm)]; } while (0)
#define CMB_ROWS(mm, P0_, P1_, X_, YA_, YB_) do { const GAS v2u* x_ = (const GAS v2u*)(X1 + (size_t)(mm) * D) + lane; const GAS v2u* y0_ = (const GAS v2u*)(YB + (size_t)(P0_) * D) + lane; \
        const GAS v2u* y1_ = (const GAS v2u*)(YB + (size_t)(P1_) * D) + lane; _Pragma("unroll") for (int j = 0; j < 8; ++j) { X_[j] = x_[64 * j]; YA_[j] = y0_[64 * j]; YB_[j] = y1_[64 * j]; } } while (0)
    const int nrow = (M + ngw - 1) / ngw, m0 = gw * nrow, m1 = (m0 + nrow < M) ? m0 + nrow : M;
    v2u xw[8], ya[8], yb[8]; f32x4 GT[8]; int bcur = -1;
    int p0 = 0, p1 = 0, p0n = 0, p1n = 0; float g0 = 0.f, g1 = 0.f, g0n = 0.f, g1n = 0.f;
    if (m0 < m1) { CMB_META(m0, p0, p1, g0, g1); CMB_ROWS(m0, p0, p1, xw, ya, yb); if (m0 + 1 < m1) CMB_META(m0 + 1, p0n, p1n, g0n, g1n); }
    for (int m = m0; m < m1; ++m) { const int b = m >> 12;
        if (b != bcur) { bcur = b; const f32x4* gt = (const f32x4*)(modl + (size_t)b * NMOD + 5 * D) + lane;
#pragma unroll
            for (int j = 0; j < 8; ++j) GT[j] = gt[64 * j]; }
        v2u xn[8], yan[8], ybn[8]; int p0nn = 0, p1nn = 0; float g0nn = 0.f, g1nn = 0.f;
        if (m + 1 < m1) CMB_ROWS(m + 1, p0n, p1n, xn, yan, ybn);
        if (m + 2 < m1) CMB_META(m + 2, p0nn, p1nn, g0nn, g1nn);
        GAS f32x4* o = (GAS f32x4*)(a.out + (size_t)m * D) + lane;
        f32x4 Y[8];
#pragma unroll
        for (int j = 0; j < 8; ++j) { const f32x4 A = (f32x4){__uint_as_float(ya[j].x << 16), __uint_as_float(ya[j].x & 0xffff0000u), __uint_as_float(ya[j].y << 16), __uint_as_float(ya[j].y & 0xffff0000u)};
            const f32x4 B = (f32x4){__uint_as_float(yb[j].x << 16), __uint_as_float(yb[j].x & 0xffff0000u), __uint_as_float(yb[j].y << 16), __uint_as_float(yb[j].y & 0xffff0000u)};
            Y[j] = A * g0 + B * g1; }
#pragma unroll
        for (int s2 = 0; s2 < 2; ++s2) { const int p = s2 ? p1 : p0; const float gs = s2 ? g1 : g0;
            if (p >= rt) {
#pragma unroll
                for (int q = 0; q < 3; ++q) { const GAS v2u* e = (const GAS v2u*)(YB2 + ((size_t)q * 2048 + (size_t)(p - rt)) * D) + lane; v2u ew[8];
#pragma unroll
                    for (int j = 0; j < 8; ++j) ew[j] = e[64 * j];
#pragma unroll
                    for (int j = 0; j < 8; ++j) Y[j] += (f32x4){__uint_as_float(ew[j].x << 16), __uint_as_float(ew[j].x & 0xffff0000u), __uint_as_float(ew[j].y << 16), __uint_as_float(ew[j].y & 0xffff0000u)} * gs; } } }
#pragma unroll
        for (int j = 0; j < 8; ++j) { const f32x4 X = (f32x4){__uint_as_float(xw[j].x << 16), __uint_as_float(xw[j].x & 0xffff0000u), __uint_as_float(xw[j].y << 16), __uint_as_float(xw[j].y & 0xffff0000u)};
            o[64 * j] = X + GT[j] * Y[j]; }
#pragma unroll
        for (int j = 0; j < 8; ++j) { xw[j] = xn[j]; ya[j] = yan[j]; yb[j] = ybn[j]; }
        p0 = p0n; p1 = p1n; g0 = g0n; g1 = g1n; p0n = p0nn; p1n = p1nn; g0n = g0nn; g1n = g1nn; }
#undef CMB_META
#undef CMB_ROWS
}

constexpr int PPL = 13, NPH = 1 + 2 * PPL;
#ifndef PH_MASK
#define PH_MASK 0xFFFFFFFFu
#endif
#ifndef ONLY_L
#define ONLY_L -1
#endif
#define PHK(k) ((k) == 0 ? 0 : (((k) - 1) % PPL) + 1)
#define IN(k) (((PH_MASK >> PHK(k)) & 1u) && lo <= (k) && (k) < hi)
#define GRID_BAR() xcd_barrier(bar)
#define SEAM(k) do { if (lo <= (k) && (k) + 1 < hi) GRID_BAR(); } while (0)
#ifndef PROBE_REP_MASK
#define PROBE_REP_MASK 0u
#endif
#define REPQ(q) (((PROBE_REP_MASK) >> (q)) & 1u)
#ifndef PROBE_PREP_X
#define PROBE_PREP_X 1
#endif


#ifdef DBG_TRACE
__device__ __forceinline__ void trace_f32(const Args& a, const float* p, size_t n, int slot, int G, int tid) {
    unsigned bad = 0; for (size_t i = (size_t)blockIdx.x * NT + tid; i < n; i += (size_t)G * NT) { const float v = fabsf(p[i]); if (!(v < 1e6f)) bad = 1; }
    if (bad) atomicOr((unsigned*)(a.ws + WS_CTL) + 40000 + slot, 1u); }
__device__ __forceinline__ void trace_bf16(const Args& a, const bf16* p, size_t n, int slot, int G, int tid) {
    unsigned bad = 0; for (size_t i = (size_t)blockIdx.x * NT + tid; i < n; i += (size_t)G * NT) { const float v = fabsf(__uint_as_float(((unsigned)p[i]) << 16)); if (!(v < 1e6f)) bad = 1; }
    if (bad) atomicOr((unsigned*)(a.ws + WS_CTL) + 40000 + slot, 1u); }
#define TRACE_F32(p, n, slot) trace_f32(a, (const float*)(p), (size_t)(n), (slot), G, tid)
#define TRACE_BF16(p, n, slot) trace_bf16(a, (const bf16*)(p), (size_t)(n), (slot), G, tid)
#else
#define TRACE_F32(p, n, slot) do { } while (0)
#define TRACE_BF16(p, n, slot) do { } while (0)
#endif
template <int L>
__device__ __forceinline__ void layer_phases(const Args& a, LAS unsigned char* lds, const XcdBarrier& bar, int lo, int hi, int tid, int lane, int wave, int G, int gw, int ngw) {
    constexpr int l = L, pb = 1 + PPL * L;
    float* MOD = (float*)(a.ws + WS_MOD);
    bf16* HB = (bf16*)(a.ws + WS_HB); bf16* OB = (bf16*)(a.ws + WS_OB); float* X1 = (float*)(a.ws + WS_X1); float* HZ = (float*)(a.ws + WS_HZ);
    bf16* ACT = (bf16*)(a.ws + WS_ACT);
    bf16* X1b = (bf16*)(a.ws + WS_X1); bf16* XAb = (bf16*)(a.ws + WS_X1 + 32 * MiB);
    const float* modl = MOD + (size_t)l * 2 * NMOD;
    if (IN(pb + 0)) { if (L == 0) adaln_rows<false, false>(a, a.in[I_X], a.in[I_N1G] + (size_t)l * D, modl, 0, D, HB, gw, ngw, lane);
        else adaln_rows<false, true>(a, XAb, a.in[I_N1G] + (size_t)l * D, modl, 0, D, HB, gw, ngw, lane); }
    SEAM(pb + 0);
    TRACE_BF16(HB, (size_t)M * D, 1 + 16 * L + 0);
    if (IN(pb + 1)) { pg8::Gemm g{HB, (const bf16*)(a.ws + WS_WIN) + (size_t)l * NHZ * D, M, NHZ, D}; pg8::StaticOrder S; S.init(M, NHZ, G, (int)blockIdx.x);
        pg8::EpiBf16 E{(bf16*)HZ, NHZ, 1 << 20}; pg8::gemm_phase<pg8::EpiBf16, pg8::StaticOrder, true, true>(lds, g, S, E); }
    SEAM(pb + 1);
    TRACE_F32(HZ, (size_t)M * NHZ, 1 + 16 * L + 1);
    if (IN(pb + 2)) {
        for (int u = blockIdx.x; u < 1536; u += G) rwkv_chunk_unit(a, l, u, lds, tid, wave, lane);
        for (int u = blockIdx.x; u < 524; u += G) {
            if (u < 256) sgu_unit(a, l, u, lds, tid, wave, lane);
            else if (u < 512) fox_prep_unit(a, l, u - 256, lds, tid, wave, lane);
            else fox_bias_unit(a, l, u - 512, lds, tid, wave, lane);
        }
    }
    if (lo <= pb + 2 && pb + 4 < hi) GRID_BAR();
    if (IN(pb + 4)) for (int rep = 0; rep < 1 + (int)REPQ(4); ++rep) {
        if (rep) GRID_BAR();
        for (int u = blockIdx.x; u < 96; u += G) { rwkv_state_unit(a, u >> 2, u & 3, lds, wave, lane); __syncthreads(); }
        {
            unsigned* ctr = (unsigned*)(a.ws + WS_CTL) + CW_ATQ + 64 * (2 * L + rep);
            volatile LAS unsigned* nxt = (volatile LAS unsigned*)(lds + MISC_OFF + 64);
            for (;;) {
                if (tid == 0) *nxt = xb_add(ctr, 1u);
                __syncthreads();
                const int u = (int)*nxt;
                __syncthreads();
                if (u >= 384) break;
                attn_unit(a, l, u % 12, 31 - u / 12, lds, tid, wave, lane);
            }
        }
    }
    SEAM(pb + 4);
    TRACE_BF16(a.ws + WS_CHHS, (size_t)1536 * 4096, 1 + 16 * L + 5);
#ifdef DBG_TRACE
    {   unsigned bad0 = 0, bad1 = 0, bad2 = 0;
        for (size_t i = (size_t)blockIdx.x * NT + tid; i < (size_t)M * D; i += (size_t)G * NT) { const float v = fabsf(__uint_as_float(((unsigned)OB[i]) << 16)); const int c = (int)(i & 2047);
            if (!(v < 1e6f)) { if (c < 768) bad0 = 1; else if (c < 1536) bad1 = 1; else bad2 = 1; } }
        unsigned* sl = (unsigned*)(a.ws + WS_CTL) + 40000 + 1 + 16 * L;
        if (bad0) atomicOr(sl + 15, 1u); if (bad2) atomicOr(sl + 15, 1u); if (bad1) atomicOr(sl + 6, 1u); }
#endif
    if (IN(pb + 5)) rwkv_out_pass(a, l, gw, ngw, lane);
    if (lo <= pb + 5 && pb + 7 < hi) GRID_BAR();
    TRACE_F32(a.ws + WS_Y, (size_t)M * RW, 1 + 16 * L + 6);
#ifdef DBG_TRACE
    {   unsigned bad0 = 0, bad1 = 0, bad2 = 0;
        for (size_t i = (size_t)blockIdx.x * NT + tid; i < (size_t)M * D; i += (size_t)G * NT) { const float v = fabsf(__uint_as_float(((unsigned)OB[i]) << 16)); const int c = (int)(i & 2047);
            if (!(v < 1e6f)) { if (c < 768) bad0 = 1; else if (c < 1536) bad1 = 1; else bad2 = 1; } }
        unsigned* sl = (unsigned*)(a.ws + WS_CTL) + 40000 + 1 + 16 * L;
        if (bad0) atomicOr(sl + 7, 1u); if (bad1) atomicOr(sl + 9, 1u); if (bad2) atomicOr(sl + 10, 1u); }
#endif
    if (IN(pb + 7)) { pg8::Gemm g{OB, (const bf16*)(a.ws + WS_WOUT) + (size_t)l * D * D, M, D, D}; pg8::StaticOrder S; S.init(M, D, G, (int)blockIdx.x);
        if constexpr (L == 0) { pg8::EpiResB<false> E{a.in[I_X], X1b, modl + 2 * D, NMOD}; pg8::gemm_phase<pg8::EpiResB<false>, pg8::StaticOrder, true, true>(lds, g, S, E); }
        else { pg8::EpiResB<true> E{XAb, X1b, modl + 2 * D, NMOD}; pg8::gemm_phase<pg8::EpiResB<true>, pg8::StaticOrder, true, true>(lds, g, S, E); } }
    SEAM(pb + 7);
    TRACE_F32(X1, (size_t)M * D, 1 + 16 * L + 11);
    if constexpr (L == 0) {
        if (IN(pb + 8)) adaln_rows<false, true>(a, X1b, a.in[I_N2G] + (size_t)l * D, modl, 3 * D, 4 * D, HB, gw, ngw, lane);
        if (lo <= pb + 8 && pb + 10 < hi) GRID_BAR();
        if (IN(pb + 10)) { pg8::Gemm g{HB, (const bf16*)(a.ws + WS_W13), M, 2 * DFF, D}; pg8::StaticOrder S; S.init(M, 2 * DFF, G, (int)blockIdx.x);
            pg8::EpiSwiGLU E{ACT, DFF, 44}; pg8::gemm_phase<pg8::EpiSwiGLU, pg8::StaticOrder, true, true>(lds, g, S, E); }
        SEAM(pb + 10);
        if (IN(pb + 11)) { pg8::Gemm g{ACT, (const bf16*)(a.ws + WS_W2T), M, D, DFF}; pg8::StaticOrder S; S.init(M, D, G, (int)blockIdx.x);
            pg8::EpiResB<true> E{X1b, XAb, modl + 5 * D, NMOD}; pg8::gemm_phase<pg8::EpiResB<true>, pg8::StaticOrder, true, true>(lds, g, S, E); }
        if (lo <= pb + 11 && pb + 13 < hi) GRID_BAR();
    } else {
        if (IN(pb + 8)) adaln_rows<true, true>(a, X1b, a.in[I_N2G] + (size_t)l * D, modl, 3 * D, 4 * D, (bf16*)(a.ws + WS_HS), gw, ngw, lane, lds, tid);
        if (lo <= pb + 8 && pb + 10 < hi) GRID_BAR();
        if (IN(pb + 10)) { pg8::MoeOrder S; moe_tile_bases(a, S.t1, S.t2, S.t3, S.t4, S.t5, S.t6, S.t7, S.t8); S.ncol = 22; S.G = G; S.c = (int)blockIdx.x;
            pg8::Gemm g{(const bf16*)(a.ws + WS_HS), (const bf16*)(a.ws + WS_MW13), MOE_ROWS, 8 * DFF, D};
            pg8::EpiSwiGLU E{ACT, DFE, 22}; pg8::gemm_phase<pg8::EpiSwiGLU, pg8::MoeOrder, true, true>(lds, g, S, E); }
        SEAM(pb + 10);
        if (IN(pb + 11)) { pg8::MoeOrderSK S; moe_tile_bases(a, S.t1, S.t2, S.t3, S.t4, S.t5, S.t6, S.t7, S.t8); S.ncol = 8; S.G = G; S.c = (int)blockIdx.x; S.full = moe_sk_full(S.t8, G);
            pg8::Gemm g{ACT, (const bf16*)(a.ws + WS_MW2T), MOE_ROWS, 8 * D, DFE};
            pg8::EpiBf16SK E{(bf16*)(a.ws + WS_YB), (bf16*)(a.ws + WS_YB2), D, 8, (S.full >> 3) * 256}; pg8::gemm_phase<pg8::EpiBf16SK, pg8::MoeOrderSK, true, true>(lds, g, S, E); }
        SEAM(pb + 11);
        if (IN(pb + 12)) moe_combine(a, modl, gw, ngw, lane);
    }
}

__global__ void __launch_bounds__(NT, 2) fwd_kernel(Args a) {
    extern __shared__ __attribute__((aligned(16))) unsigned char lds_raw[];
    LAS unsigned char* lds = (LAS unsigned char*)lds_raw;
    const int tid = threadIdx.x, lane = tid & 63, wave = __builtin_amdgcn_readfirstlane(tid >> 6);
    const int G = gridDim.x, gw = blockIdx.x * NWAVES + wave, ngw = G * NWAVES;
    volatile LAS unsigned* MISC = (volatile LAS unsigned*)(lds + MISC_OFF);
    for (int u = tid; u < (LDS_BYTES - 131072) / 4; u += NT) ((LAS unsigned*)(lds + 131072))[u] = 0u;
    __syncthreads();
    const int lo = a.ph_lo, hi = a.ph_hi;
    XcdBarrier bar = xcd_barrier_post((unsigned*)(a.ws + WS_CTL) + CW_BAR, MISC + 8);
    if (IN(0)) { if (blockIdx.x == 0 && tid < 8) ((unsigned*)(a.ws + WS_CTL))[CW_CNT + 64 * tid] = 0u;
        p0_mod(a, lds, tid, wave, lane); p0_convert(a, lds, gw, ngw, wave, lane); }
    SEAM(0);
#ifdef DBG_TRACE
    trace_bf16(a, (const bf16*)(a.ws + WS_WIN), (size_t)394 * MiB / 2, 39, G, tid); trace_f32(a, (const float*)(a.ws + WS_MOD), 4 * NMOD, 39, G, tid);
#endif
    if (ONLY_L < 0 || ONLY_L == 0) layer_phases<0>(a, lds, bar, lo, hi, tid, lane, wave, G, gw, ngw);
    if (ONLY_L < 0 || ONLY_L == 1) layer_phases<1>(a, lds, bar, lo, hi, tid, lane, wave, G, gw, ngw);
#ifdef DBG_TRACE
    {   unsigned* slots = (unsigned*)(a.ws + WS_CTL) + 40000;
        GRID_BAR();
        for (size_t i = (size_t)blockIdx.x * NT + tid; i < (size_t)M * D; i += (size_t)G * NT) a.out[i] = a.in[I_X][i];
        GRID_BAR();
        if (blockIdx.x == 0 && tid == 0) { unsigned c = 0; const int order[16] = {0, 1, 2, 12, 13, 14, 3, 4, 5, 15, 6, 7, 9, 10, 11, 8};
            if (xb_ld(slots + 39)) c = 1;
            if (xb_ld(slots + 38)) { a.out[0] = (10.0f + 0.5f * (float)(xb_ld(slots + 38) & 127u)) * 100.0f; return; }
            for (int L2 = 0; L2 < 2 && !c; ++L2) for (int j = 0; j < 16; ++j) if (xb_ld(slots + 1 + 16 * L2 + order[j])) { c = 2 + 16 * L2 + j; break; }
            a.out[0] = (10.0f + (float)c) * 100.0f; }
    }
#endif
}
#undef IN
#undef SEAM

extern "C" void kernel_launch(void* const* d_in, const int* in_sizes, int n_in, void* d_out, int out_size, void* d_ws, size_t ws_size, hipStream_t stream) {
    static int grid = 0;
    if (grid == 0) {
        if (n_in != 34 || out_size != M * D || ws_size < WS_END) { fprintf(stderr, "kernel_launch: unexpected shapes (n_in %d out %d ws %zu need %zu)\n", n_in, out_size, ws_size, (size_t)WS_END); grid = -1; return; }
        int dev = 0, cus = 0, per_cu = 0;
        if (hipGetDevice(&dev) != hipSuccess || hipDeviceGetAttribute(&cus, hipDeviceAttributeMultiprocessorCount, dev) != hipSuccess) { grid = -1; return; }
        if (hipFuncSetAttribute((const void*)fwd_kernel, hipFuncAttributeMaxDynamicSharedMemorySize, LDS_BYTES) != hipSuccess) { fprintf(stderr, "kernel_launch: hipFuncSetAttribute failed\n"); grid = -1; return; }
        if (hipOccupancyMaxActiveBlocksPerMultiprocessor(&per_cu, (const void*)fwd_kernel, NT, LDS_BYTES) != hipSuccess || per_cu < 1) { fprintf(stderr, "kernel_launch: occupancy query says %d\n", per_cu); }
        (void)hipGetLastError();
        grid = cus;
    }
    if (grid < 0) return;
    (void)hipMemsetAsync((char*)d_ws + WS_CTL, 0, CTL_ZERO_BYTES, stream);
    Args a{};
    for (int i = 0; i < 34; ++i) a.in[i] = (const float*)d_in[i];
    a.out = (float*)d_out; a.ws = (unsigned char*)d_ws;
    a.ph_lo = 0; a.ph_hi = NPH;
    hipLaunchKernelGGL(fwd_kernel, dim3(grid), dim3(NT), LDS_BYTES, stream, a);
}
```
